# Optimizing an MI355X kernel written in HIP

```python
import jax, jax.numpy as jnp
from jax import lax
import numpy as np

D_MODEL = 1024
BATCH = 2
SEQ = 8192
DEPTH = 2

N_META = 16
D_MIX = D_MODEL
ATTN_HEADS = 8
HEAD_DIM = 64
D_ATTN = ATTN_HEADS * HEAD_DIM
D_CONF = D_MIX // 4
D_SC = D_MIX - D_ATTN - D_CONF
CONF_KERNEL = 31
SC_KERNEL = 3
D_FF = 4 * D_MODEL
Q_BLOCK = 128
EPS = 1e-6
N_IN = 3 * D_ATTN + ATTN_HEADS + 2 * D_CONF + 3 * D_SC

kernel_name = 'hybrid_fox_conformer_shortconv_block'


def _rmsnorm(x, g):
    xf = x.astype(jnp.float32)
    y = xf * lax.rsqrt(jnp.mean(xf * xf, axis=-1, keepdims=True) + EPS)
    return (y * g.astype(jnp.float32)).astype(x.dtype)


def _layernorm(x, g, b):
    xf = x.astype(jnp.float32)
    mu = jnp.mean(xf, axis=-1, keepdims=True)
    xc = xf - mu
    y = xc * lax.rsqrt(jnp.mean(xc * xc, axis=-1, keepdims=True) + EPS)
    return (y * g.astype(jnp.float32) + b.astype(jnp.float32)).astype(x.dtype)


def _causal_dwconv(x, w):
    K, C = w.shape
    return lax.conv_general_dilated(
        x, w[:, None, :].astype(x.dtype), window_strides=(1,), padding=[(K - 1, 0)],
        dimension_numbers=('NWC', 'WIO', 'NWC'), feature_group_count=C)


def _fox_attend(q_blk, c_q, q_pos, k, v, c_k, k_pos):
    s = jnp.einsum('bhqd,bhkd->bhqk', q_blk, k, preferred_element_type=jnp.float32) * (HEAD_DIM ** -0.5)
    s = s + c_q[..., :, None] - c_k[..., None, :]
    s = jnp.where(q_pos[:, None] >= k_pos[None, :], s, -jnp.inf)
    p = jax.nn.softmax(s, axis=-1)
    return jnp.einsum('bhqk,bhkd->bhqd', p.astype(v.dtype), v)


def _fox_attention(q, k, v, log_f):
    bsz, L, H, dh = q.shape
    n_real = L - N_META
    nb = n_real // Q_BLOCK
    c = jnp.cumsum(log_f, axis=1).transpose(0, 2, 1)
    qh = q.transpose(0, 2, 1, 3)
    kh = k.transpose(0, 2, 1, 3)
    vh = v.transpose(0, 2, 1, 3)
    k_pos = jnp.arange(L)
    meta_out = _fox_attend(qh[:, :, :N_META], c[:, :, :N_META], k_pos[:N_META],
                           kh[:, :, :N_META], vh[:, :, :N_META], c[:, :, :N_META], k_pos[:N_META])
    q_blocks = qh[:, :, N_META:].reshape(bsz, H, nb, Q_BLOCK, dh).transpose(2, 0, 1, 3, 4)
    c_blocks = c[:, :, N_META:].reshape(bsz, H, nb, Q_BLOCK).transpose(2, 0, 1, 3)

    def body(args):
        q_blk, c_q, i = args
        q_pos = N_META + i * Q_BLOCK + jnp.arange(Q_BLOCK)
        return _fox_attend(q_blk, c_q, q_pos, kh, vh, c, k_pos)

    real_out = lax.map(body, (q_blocks, c_blocks, jnp.arange(nb)))
    real_out = real_out.transpose(1, 0, 3, 2, 4).reshape(bsz, n_real, H * dh)
    meta_out = meta_out.transpose(0, 2, 1, 3).reshape(bsz, N_META, H * dh)
    return jnp.concatenate([meta_out, real_out], axis=1)


def setup_inputs(seed: int = 0) -> dict:
    key = jax.random.key(seed)
    ks = jax.random.split(key, 20)
    nrm = jax.random.normal
    f32 = jnp.float32
    return {
        'x': nrm(ks[0], (BATCH, SEQ, D_MODEL), f32),
        'meta_tokens': nrm(ks[1], (N_META, D_MODEL), f32),
        'mix_norm_g': 1.0 + 0.1 * nrm(ks[2], (DEPTH, D_MODEL), f32),
        'w_in': nrm(ks[3], (DEPTH, D_MODEL, N_IN), f32) * D_MODEL ** -0.5,
        'b_forget': jax.random.uniform(ks[4], (DEPTH, ATTN_HEADS), f32, 1.0, 5.0),
        'w_conf_dw': nrm(ks[5], (DEPTH, CONF_KERNEL, D_CONF), f32) * CONF_KERNEL ** -0.5,
        'b_conf_dw': 0.02 * nrm(ks[6], (DEPTH, D_CONF), f32),
        'conf_ln_g': 1.0 + 0.1 * nrm(ks[7], (DEPTH, D_CONF), f32),
        'conf_ln_b': 0.02 * nrm(ks[8], (DEPTH, D_CONF), f32),
        'w_conf_pw': nrm(ks[9], (DEPTH, D_CONF, D_CONF), f32) * D_CONF ** -0.5,
        'b_conf_pw': 0.02 * nrm(ks[10], (DEPTH, D_CONF), f32),
        'w_sc_conv': nrm(ks[11], (DEPTH, SC_KERNEL, D_SC), f32) * SC_KERNEL ** -0.5,
        'w_out': nrm(ks[12], (DEPTH, D_MIX, D_MODEL), f32) * D_MIX ** -0.5,
        'mlp_norm_g': 1.0 + 0.1 * nrm(ks[13], (DEPTH, D_MODEL), f32),
        'w_mlp1': nrm(ks[14], (DEPTH, D_MODEL, D_FF), f32) * D_MODEL ** -0.5,
        'w_mlp2': nrm(ks[15], (DEPTH, D_FF, D_MODEL), f32) * D_FF ** -0.5,
        'final_norm_g': 1.0 + 0.1 * nrm(ks[16], (D_MODEL,), f32),
    }


def reference(x, meta_tokens, mix_norm_g, w_in, b_forget, w_conf_dw, b_conf_dw, conf_ln_g,
              conf_ln_b, w_conf_pw, b_conf_pw, w_sc_conv, w_out, mlp_norm_g, w_mlp1, w_mlp2,
              final_norm_g):
    bsz = x.shape[0]
    meta = jnp.broadcast_to(meta_tokens[None].astype(x.dtype), (bsz, N_META, D_MODEL))
    h = jnp.concatenate([meta, x], axis=1)
    L = h.shape[1]
    sizes = [D_ATTN, D_ATTN, D_ATTN, ATTN_HEADS, D_CONF, D_CONF, D_SC, D_SC, D_SC]
    splits = np.cumsum(sizes)[:-1].tolist()
    for l in range(DEPTH):
        hn = _rmsnorm(h, mix_norm_g[l])
        proj = hn @ w_in[l]
        q, k, v, f_logit, conf_a, conf_gate, sc_b, sc_c, sc_u = jnp.split(proj, splits, axis=-1)
        log_f = jax.nn.log_sigmoid(f_logit.astype(jnp.float32) + b_forget[l].astype(jnp.float32))
        attn = _fox_attention(q.reshape(bsz, L, ATTN_HEADS, HEAD_DIM),
                              k.reshape(bsz, L, ATTN_HEADS, HEAD_DIM),
                              v.reshape(bsz, L, ATTN_HEADS, HEAD_DIM), log_f)
        glu = conf_a * jax.nn.sigmoid(conf_gate)
        dw = _causal_dwconv(glu, w_conf_dw[l]) + b_conf_dw[l]
        conf = jax.nn.silu(_layernorm(dw, conf_ln_g[l], conf_ln_b[l])) @ w_conf_pw[l] + b_conf_pw[l]
        sc = sc_b * _causal_dwconv(sc_c * sc_u, w_sc_conv[l])
        h = h + jnp.concatenate([attn, conf, sc], axis=-1) @ w_out[l]
        hn = _rmsnorm(h, mlp_norm_g[l])
        h = h + jnp.square(jax.nn.relu(hn @ w_mlp1[l])) @ w_mlp2[l]
    out = _rmsnorm(h, final_norm_g)
    return out[:, N_META:]
```

```cpp
#include <hip/hip_runtime.h>
#include <cstdint>
#include <cmath>

namespace nv {
constexpr int D = 1024, B = 2, S = 8192, NM = 16, L = S + NM, H = 8, HD = 64, DA = 512, DC = 256, DS = 256;
constexpr int NIN = 3 * DA + H + 2 * DC + 3 * DS;
constexpr int FF = 4096, CK = 31, SK = 3;
constexpr float EPS = 1e-6f;
constexpr int OQ = 0, OK_ = 512, OV = 1024, OF = 1536, OCA = 1544, OCG = 1800, OSB = 2056, OSC = 2312, OSU = 2568;

__global__ void build_h(const float* __restrict__ x, const float* __restrict__ meta, float* __restrict__ h) {
    const size_t i = (size_t)blockIdx.x * 256 + threadIdx.x;
    const size_t total = (size_t)B * L * D / 4;
    if (i >= total) return;
    const size_t e = i * 4; const int col = (int)(e % D); const size_t row = e / D; const int b = (int)(row / L), t = (int)(row % L);
    float4 v;
    if (t < NM) v = *(const float4*)(meta + (size_t)t * D + col);
    else v = *(const float4*)(x + ((size_t)b * S + (t - NM)) * D + col);
    *(float4*)(h + e) = v;
}

__global__ void row_rstd(const float* __restrict__ h, float* __restrict__ rstd, int M) {
    const int wave = (blockIdx.x * 256 + threadIdx.x) >> 6, lane = threadIdx.x & 63;
    if (wave >= M) return;
    const float4* r = (const float4*)(h + (size_t)wave * D);
    float s = 0.f;
    for (int j = 0; j < 4; ++j) { float4 v = r[lane + 64 * j]; s += v.x * v.x + v.y * v.y + v.z * v.z + v.w * v.w; }
    for (int o = 32; o > 0; o >>= 1) s += __shfl_xor(s, o);
    if (lane == 0) rstd[wave] = 1.0f / sqrtf(s / D + EPS);
}

template <int EPI>
__global__ void __launch_bounds__(256) gemm_naive(const float* __restrict__ A, int lda, const float* __restrict__ rstd, const float* __restrict__ g,
                                                  const float* __restrict__ W, int N, int K, float* C, int ldc, const float* R, int M) {
    __shared__ float As[16][68];
    __shared__ float Bs[16][68];
    const int tid = threadIdx.x, tx = tid & 15, ty = tid >> 4;
    const int m0 = blockIdx.y * 64, n0 = blockIdx.x * 64;
    float acc[4][4] = {};
    const int ar = tid >> 2, ak = (tid & 3) * 4;
    const int bk = tid >> 4, bn = (tid & 15) * 4;
    const int arow = m0 + ar;
    const float rs = (arow < M && rstd) ? rstd[arow] : 1.0f;
    for (int k0 = 0; k0 < K; k0 += 16) {
        float4 av = make_float4(0.f, 0.f, 0.f, 0.f);
        if (arow < M) { av = *(const float4*)(A + (size_t)arow * lda + k0 + ak);
            if (g) { const float4 gv = *(const float4*)(g + k0 + ak); av.x *= gv.x; av.y *= gv.y; av.z *= gv.z; av.w *= gv.w; }
            av.x *= rs; av.y *= rs; av.z *= rs; av.w *= rs; }
        float4 bv = make_float4(0.f, 0.f, 0.f, 0.f);
        if (n0 + bn < N) bv = *(const float4*)(W + (size_t)(k0 + bk) * N + n0 + bn);
        __syncthreads();
        As[ak + 0][ar] = av.x; As[ak + 1][ar] = av.y; As[ak + 2][ar] = av.z; As[ak + 3][ar] = av.w;
        *(float4*)&Bs[bk][bn] = bv;
        __syncthreads();
#pragma unroll
        for (int k = 0; k < 16; ++k) {
            const float4 a4 = *(const float4*)&As[k][ty * 4];
            const float4 b4 = *(const float4*)&Bs[k][tx * 4];
            const float a[4] = {a4.x, a4.y, a4.z, a4.w}, b[4] = {b4.x, b4.y, b4.z, b4.w};
#pragma unroll
            for (int i = 0; i < 4; ++i)
#pragma unroll
                for (int j = 0; j < 4; ++j) acc[i][j] = fmaf(a[i], b[j], acc[i][j]);
        }
    }
#pragma unroll
    for (int i = 0; i < 4; ++i) {
        const int row = m0 + ty * 4 + i; if (row >= M) continue;
        const int col = n0 + tx * 4; if (col >= N) continue;
        float4 o = make_float4(acc[i][0], acc[i][1], acc[i][2], acc[i][3]);
        if (EPI == 1) { const float4 r = *(const float4*)(R + (size_t)row * ldc + col); o.x += r.x; o.y += r.y; o.z += r.z; o.w += r.w; }
        if (EPI == 2) { o.x = fmaxf(o.x, 0.f); o.y = fmaxf(o.y, 0.f); o.z = fmaxf(o.z, 0.f); o.w = fmaxf(o.w, 0.f); o.x *= o.x; o.y *= o.y; o.z *= o.z; o.w *= o.w; }
        *(float4*)(C + (size_t)row * ldc + col) = o;
    }
}

__global__ void __launch_bounds__(256) fox_cumsum(const float* __restrict__ proj, const float* __restrict__ bfv, float* __restrict__ c) {
    __shared__ double tot[256];
    const int h = blockIdx.x, tid = threadIdx.x; const float bb = bfv[h];
    const int CH = (L + 255) / 256, t0 = tid * CH, t1 = min(t0 + CH, L);
    double acc = 0.0;
    for (int t = t0; t < t1; ++t) { const float xx = proj[(size_t)t * NIN + OF + h] + bb; acc += (double)(fminf(xx, 0.f) - log1pf(expf(-fabsf(xx)))); }
    tot[tid] = acc;
    __syncthreads();
    if (tid == 0) { double run = 0.0; for (int i = 0; i < 256; ++i) { const double v = tot[i]; tot[i] = run; run += v; } }
    __syncthreads();
    acc = tot[tid];
    for (int t = t0; t < t1; ++t) { const float xx = proj[(size_t)t * NIN + OF + h] + bb; acc += (double)(fminf(xx, 0.f) - log1pf(expf(-fabsf(xx)))); c[h * L + t] = (float)acc; }
}

__global__ void __launch_bounds__(256) fox_attn(const float* __restrict__ proj, const float* __restrict__ c, float* __restrict__ mix) {
    __shared__ float sh[2 * 64 * 64 + 64];
    float (*Ks)[64] = (float (*)[64])sh;
    float (*Vs)[64] = (float (*)[64])(sh + 4096);
    float* cks = sh + 8192;
    const int h = blockIdx.y, q0 = blockIdx.x * 64, tid = threadIdx.x, ql = tid & 63, part = tid >> 6;
    const int qpos = q0 + ql; const bool qvalid = qpos < L;
    float q[64];
    {
        const float* qp = proj + (size_t)(qvalid ? qpos : 0) * NIN + OQ + h * HD;
#pragma unroll
        for (int d = 0; d < 64; d += 4) { const float4 v = *(const float4*)(qp + d); q[d] = v.x * 0.125f; q[d + 1] = v.y * 0.125f; q[d + 2] = v.z * 0.125f; q[d + 3] = v.w * 0.125f; }
    }
    const float cq = c[h * L + (qvalid ? qpos : 0)];
    float m = -INFINITY, l = 0.f; float o[64];
#pragma unroll
    for (int d = 0; d < 64; ++d) o[d] = 0.f;
    const int last_key = min(q0 + 63, L - 1);
    for (int k0 = 0; k0 <= last_key; k0 += 64) {
        __syncthreads();
        for (int i = tid; i < 64 * 16; i += 256) { const int r = i >> 4, c4 = (i & 15) * 4; const int kp = k0 + r;
            float4 kv = make_float4(0.f, 0.f, 0.f, 0.f), vv = kv;
            if (kp < L) { kv = *(const float4*)(proj + (size_t)kp * NIN + OK_ + h * HD + c4); vv = *(const float4*)(proj + (size_t)kp * NIN + OV + h * HD + c4); }
            *(float4*)&Ks[r][c4] = kv; *(float4*)&Vs[r][c4] = vv; }
        if (tid < 64) cks[tid] = (k0 + tid < L) ? c[h * L + k0 + tid] : 0.f;
        __syncthreads();
        for (int kk = 0; kk < 16; ++kk) {
            const int r = part * 16 + kk, kp = k0 + r;
            if (kp > qpos || kp >= L) continue;
            float s = 0.f;
#pragma unroll
            for (int d = 0; d < 64; ++d) s = fmaf(q[d], Ks[r][d], s);
            s += cq - cks[r];
            const float mn = fmaxf(m, s); const float a = __expf(m - mn), p = __expf(s - mn);
            l = l * a + p;
#pragma unroll
            for (int d = 0; d < 64; ++d) o[d] = fmaf(o[d], a, p * Vs[r][d]);
            m = mn;
        }
    }
    __syncthreads();
    float* Os = sh; float* ms = sh + 64 * 65; float* ls = ms + 256;
    ms[part * 64 + ql] = m; ls[part * 64 + ql] = l;
    __syncthreads();
    const float M = fmaxf(fmaxf(ms[ql], ms[64 + ql]), fmaxf(ms[128 + ql], ms[192 + ql]));
    float Ltot = 0.f;
#pragma unroll
    for (int p2 = 0; p2 < 4; ++p2) { const float mm = ms[p2 * 64 + ql]; Ltot += (mm == -INFINITY) ? 0.f : ls[p2 * 64 + ql] * __expf(mm - M); }
    const float sc = (m == -INFINITY) ? 0.f : __expf(m - M) / Ltot;
    for (int p2 = 0; p2 < 4; ++p2) {
        if (part == p2) {
#pragma unroll
            for (int d = 0; d < 64; ++d) { if (p2 == 0) Os[ql * 65 + d] = o[d] * sc; else Os[ql * 65 + d] += o[d] * sc; }
        }
        __syncthreads();
    }
    for (int i = tid; i < 64 * 64; i += 256) { const int r = i >> 6, d = i & 63; if (q0 + r < L) mix[(size_t)(q0 + r) * D + h * HD + d] = Os[r * 65 + d]; }
}

__global__ void __launch_bounds__(256) conformer(const float* __restrict__ proj, const float* __restrict__ wdw, const float* __restrict__ bdw, const float* __restrict__ lng,
                                                 const float* __restrict__ lnb, const float* __restrict__ wpw, const float* __restrict__ bpw, float* __restrict__ mix) {
    __shared__ float ys[256];
    __shared__ float red[8];
    const int t = blockIdx.x, cch = threadIdx.x, lane = cch & 63, wv = cch >> 6;
    float dw = bdw[cch];
    for (int k = 0; k < CK; ++k) { const int tt = t - (CK - 1) + k; if (tt < 0) continue;
        const float a = proj[(size_t)tt * NIN + OCA + cch], gt = proj[(size_t)tt * NIN + OCG + cch];
        dw = fmaf(wdw[k * DC + cch], a / (1.f + __expf(-gt)), dw); }
    float s = dw;
    for (int o = 32; o > 0; o >>= 1) s += __shfl_xor(s, o);
    if (lane == 0) red[wv] = s;
    __syncthreads();
    const float mu = (red[0] + red[1] + red[2] + red[3]) * (1.f / DC);
    const float xc = dw - mu; float s2 = xc * xc;
    for (int o = 32; o > 0; o >>= 1) s2 += __shfl_xor(s2, o);
    if (lane == 0) red[4 + wv] = s2;
    __syncthreads();
    const float var = (red[4] + red[5] + red[6] + red[7]) * (1.f / DC);
    const float y = xc * (1.0f / sqrtf(var + EPS)) * lng[cch] + lnb[cch];
    ys[cch] = y / (1.f + __expf(-y));
    __syncthreads();
    float acc = bpw[cch];
    for (int c2 = 0; c2 < DC; ++c2) acc = fmaf(ys[c2], wpw[c2 * DC + cch], acc);
    mix[(size_t)t * D + DA + cch] = acc;
}

__global__ void shortconv(const float* __restrict__ proj, const float* __restrict__ wsc, float* __restrict__ mix) {
    const int idx = blockIdx.x * 256 + threadIdx.x; const int t = idx >> 8, cch = idx & 255;
    if (t >= L) return;
    float acc = 0.f;
    for (int k = 0; k < SK; ++k) { const int tt = t - (SK - 1) + k; if (tt < 0) continue;
        acc = fmaf(wsc[k * DS + cch], proj[(size_t)tt * NIN + OSC + cch] * proj[(size_t)tt * NIN + OSU + cch], acc); }
    mix[(size_t)t * D + DA + DC + cch] = proj[(size_t)t * NIN + OSB + cch] * acc;
}

__global__ void final_norm(const float* __restrict__ h, const float* __restrict__ g, float* __restrict__ out) {
    const int wave = (blockIdx.x * 256 + threadIdx.x) >> 6, lane = threadIdx.x & 63;
    if (wave >= B * S) return;
    const int b = wave / S, t = wave % S;
    const float4* r = (const float4*)(h + ((size_t)b * L + NM + t) * D);
    float4 v[4]; float s = 0.f;
#pragma unroll
    for (int j = 0; j < 4; ++j) { v[j] = r[lane + 64 * j]; s += v[j].x * v[j].x + v[j].y * v[j].y + v[j].z * v[j].z + v[j].w * v[j].w; }
    for (int o = 32; o > 0; o >>= 1) s += __shfl_xor(s, o);
    const float rs = 1.0f / sqrtf(s / D + EPS);
    float4* orow = (float4*)(out + (size_t)wave * D);
#pragma unroll
    for (int j = 0; j < 4; ++j) { const float4 gv = ((const float4*)g)[lane + 64 * j]; float4 o; o.x = v[j].x * rs * gv.x; o.y = v[j].y * rs * gv.y; o.z = v[j].z * rs * gv.z; o.w = v[j].w * rs * gv.w; orow[lane + 64 * j] = o; }
}
}

static void naive_forward(void* const* d_in, void* d_out, void* d_ws, hipStream_t st) {
    using namespace nv;
    const float* x = (const float*)d_in[0]; const float* meta = (const float*)d_in[1]; const float* mix_g = (const float*)d_in[2]; const float* w_in = (const float*)d_in[3];
    const float* b_f = (const float*)d_in[4]; const float* w_dw = (const float*)d_in[5]; const float* b_dw = (const float*)d_in[6]; const float* ln_g = (const float*)d_in[7];
    const float* ln_b = (const float*)d_in[8]; const float* w_pw = (const float*)d_in[9]; const float* b_pw = (const float*)d_in[10]; const float* w_sc = (const float*)d_in[11];
    const float* w_out = (const float*)d_in[12]; const float* mlp_g = (const float*)d_in[13]; const float* w1 = (const float*)d_in[14]; const float* w2 = (const float*)d_in[15];
    const float* fin_g = (const float*)d_in[16];
    char* ws = (char*)d_ws; const size_t MiB = 1u << 20;
    float* h = (float*)ws;
    float* proj = (float*)(ws + 66 * MiB);
    float* mix = (float*)(ws + (66 + 89) * MiB);
    float* hid = (float*)(ws + 66 * MiB);
    float* rstd = (float*)(ws + 200 * MiB);
    float* cbuf = (float*)(ws + 201 * MiB);
    build_h<<<(unsigned)(((size_t)B * L * D / 4 + 255) / 256), 256, 0, st>>>(x, meta, h);
    for (int l = 0; l < 2; ++l) {
        for (int b = 0; b < B; ++b) {
            float* hb = h + (size_t)b * L * D;
            row_rstd<<<(L * 64 + 255) / 256, 256, 0, st>>>(hb, rstd, L);
            gemm_naive<0><<<dim3((NIN + 63) / 64, (L + 63) / 64), 256, 0, st>>>(hb, D, rstd, mix_g + l * D, w_in + (size_t)l * D * NIN, NIN, D, proj, NIN, nullptr, L);
            fox_cumsum<<<H, 256, 0, st>>>(proj, b_f + l * H, cbuf);
            fox_attn<<<dim3((L + 63) / 64, H), 256, 0, st>>>(proj, cbuf, mix);
            conformer<<<L, 256, 0, st>>>(proj, w_dw + (size_t)l * CK * DC, b_dw + l * DC, ln_g + l * DC, ln_b + l * DC, w_pw + (size_t)l * DC * DC, b_pw + l * DC, mix);
            shortconv<<<(L * 256 + 255) / 256, 256, 0, st>>>(proj, w_sc + (size_t)l * SK * DS, mix);
            gemm_naive<1><<<dim3(D / 64, (L + 63) / 64), 256, 0, st>>>(mix, D, nullptr, nullptr, w_out + (size_t)l * D * D, D, D, hb, D, hb, L);
            row_rstd<<<(L * 64 + 255) / 256, 256, 0, st>>>(hb, rstd, L);
            gemm_naive<2><<<dim3(FF / 64, (L + 63) / 64), 256, 0, st>>>(hb, D, rstd, mlp_g + l * D, w1 + (size_t)l * D * FF, FF, D, hid, FF, nullptr, L);
            gemm_naive<1><<<dim3(D / 64, (L + 63) / 64), 256, 0, st>>>(hid, FF, nullptr, nullptr, w2 + (size_t)l * FF * D, D, FF, hb, D, hb, L);
        }
    }
    final_norm<<<(B * S * 64 + 255) / 256, 256, 0, st>>>(h, fin_g, (float*)d_out);
}

#ifndef NAIVE_NO_ENTRY
extern "C" void kernel_launch(void* const* d_in, const int* in_sizes, int n_in, void* d_out, int out_size, void* d_ws, size_t ws_size, hipStream_t stream) {
    (void)in_sizes; (void)n_in; (void)out_size; (void)ws_size;
    naive_forward(d_in, d_out, d_ws, stream);
}
#endif
```

```cpp
#include <hip/hip_runtime.h>
#include <hip/hip_bf16.h>
#include <cstdio>
#include <cstdint>
#include <cmath>
namespace pg8 {
#define PG8_LAS __attribute__((address_space(3)))
typedef unsigned short bf16_t;
typedef short bf16x8 __attribute__((ext_vector_type(8)));
typedef float f32x4 __attribute__((ext_vector_type(4)));
typedef unsigned u32x4 __attribute__((ext_vector_type(4)));
constexpr int BM = 256, BK = 64, HALF = 128, HTB = HALF * BK * 2  , STAGE_BYTES = 8 * HTB, NXCD = 8, WGM = 8;

__host__ __device__ __forceinline__ int lds_byte(int r, int c) { const int st = (r >> 4) * 2 + (c >> 5), rr = r & 15, cc = c & 31, ob = rr * 64 + cc * 2; return st * 1024 + (ob ^ (((ob >> 9) & 1) << 5)); }
__host__ __device__ __forceinline__ void stage_rc(int b, int& R, int& C) { const int st = b / 1024, sb = b % 1024, swz = sb ^ (((sb >> 9) & 1) << 5); R = (st >> 1) * 16 + swz / 64; C = (st & 1) * 32 + (swz % 64) / 2; }
__host__ __device__ __forceinline__ int perm32(int rho) { const int n = rho >> 4, i = rho & 15; return 8 * (i >> 2) + 4 * n + (i & 3); }

struct Unit { int pm, pn; };
struct Gemm { const bf16_t* A; const bf16_t* Bt; int M, N, K; };

struct StaticOrder {
    int nM, nN, nwg, G, c;
    __host__ __device__ void init(int M, int N, int G_, int c_) { nM = M / BM; nN = N / BM; nwg = nM * nN; G = G_; c = c_; }
    __host__ __device__ bool next(int i, Unit& u) const {
        const long L = (long)i * G + c; if (L >= nwg) return false;
        int wgid = (int)L; { const int q = nwg / NXCD, r = nwg % NXCD, xcd = wgid % NXCD, off = wgid / NXCD; wgid = (xcd < r ? xcd * (q + 1) : r * (q + 1) + (xcd - r) * q) + off; }
        const int nig = WGM * nN, gid = wgid / nig, fm = gid * WGM, gsz = (nM - fm) < WGM ? (nM - fm) : WGM;
        u.pm = fm + ((wgid % nig) % gsz); u.pn = (wgid % nig) / gsz; return true;
    }
    __device__ __forceinline__ void a_ready(const Unit&) const {}
    __device__ __forceinline__ void done(const Unit&) const {}
};

__device__ __forceinline__ unsigned cvt_pk_bf16(float lo, float hi) { unsigned r; asm volatile("v_cvt_pk_bf16_f32 %0, %1, %2" : "=v"(r) : "v"(lo), "v"(hi)); return r; }
constexpr float RMS_EPS = 1e-6f;
constexpr int IN_KPAD = 128, IN_CPAD = 48;
__device__ __forceinline__ float rstd_of(float ss) { return 1.0f / sqrtf(ss * (1.0f / 1024.0f) + RMS_EPS); }
struct EpiIn {
    static constexpr bool PERM = true, AFTER_DRAIN = false;
    bf16_t* Q; bf16_t* Kb; bf16_t* Vb; bf16_t* CB; size_t cb_stride; const float* rowss; float c2;
    __device__ __forceinline__ void operator()(const f32x4 (&acc)[2][2][4][2], const Unit& u, int wr, int wc, int fr, int fq) const {
        const int b = u.pm >> 5, pn = u.pn;
        bf16_t* base; int ldc, radd; float sc = 1.f;
        if (pn < 2) { base = Q + pn * 256; ldc = 512; radd = 0; sc = c2; }
        else if (pn < 4) { base = Kb + (pn - 2) * 256; ldc = 512; radd = (b + 1) * IN_KPAD; }
        else if (pn < 6) { base = Vb + (pn - 4) * 256; ldc = 512; radd = (b + 1) * IN_KPAD; }
        else { base = CB + (size_t)(pn - 6) * cb_stride; ldc = 256; radd = (b + 1) * IN_CPAD; }
        const int row0 = u.pm * BM + wr * 64 + fr, col0 = wc * 32 + 8 * fq;
#pragma unroll
        for (int ai = 0; ai < 2; ++ai)
#pragma unroll
            for (int m = 0; m < 4; ++m) { const int row = row0 + ai * HALF + m * 16; const float rs = rstd_of(rowss[row]) * sc;
                bf16_t* rowp = base + (size_t)(row + radd) * ldc + col0;
#pragma unroll
                for (int bj = 0; bj < 2; ++bj) { const f32x4 v0 = acc[ai][bj][m][0] * rs, v1 = acc[ai][bj][m][1] * rs;
                    u32x4 w; w.x = cvt_pk_bf16(v0[0], v0[1]); w.y = cvt_pk_bf16(v0[2], v0[3]); w.z = cvt_pk_bf16(v1[0], v1[1]); w.w = cvt_pk_bf16(v1[2], v1[3]);
                    *(u32x4*)(rowp + bj * HALF) = w; } }
    }
};
struct EpiUp {
    static constexpr bool PERM = true, AFTER_DRAIN = false;
    bf16_t* O; int ldc; const float* rowss;
    __device__ __forceinline__ void operator()(const f32x4 (&acc)[2][2][4][2], const Unit& u, int wr, int wc, int fr, int fq) const {
        const int row0 = u.pm * BM + wr * 64 + fr, col0 = u.pn * BM + wc * 32 + 8 * fq;
#pragma unroll
        for (int ai = 0; ai < 2; ++ai)
#pragma unroll
            for (int m = 0; m < 4; ++m) { const int row = row0 + ai * HALF + m * 16; const float rs = rstd_of(rowss[row]);
                bf16_t* rowp = O + (size_t)row * ldc + col0;
#pragma unroll
                for (int bj = 0; bj < 2; ++bj) { f32x4 v0 = acc[ai][bj][m][0] * rs, v1 = acc[ai][bj][m][1] * rs;
                    v0 = __builtin_elementwise_max(v0, (f32x4){0.f, 0.f, 0.f, 0.f}); v1 = __builtin_elementwise_max(v1, (f32x4){0.f, 0.f, 0.f, 0.f}); v0 = v0 * v0; v1 = v1 * v1;
                    u32x4 w; w.x = cvt_pk_bf16(v0[0], v0[1]); w.y = cvt_pk_bf16(v0[2], v0[3]); w.z = cvt_pk_bf16(v1[0], v1[1]); w.w = cvt_pk_bf16(v1[2], v1[3]);
                    *(u32x4*)(rowp + bj * HALF) = w; } }
    }
};
struct EpiRes {
    static constexpr bool PERM = false, AFTER_DRAIN = false;
    const float* base; float* out; bf16_t* xb; float* rowss;
    __device__ __forceinline__ void operator()(const f32x4 (&acc)[2][2][4][2], const Unit& u, int wr, int wc, int fr, int fq) const {
        typedef unsigned u32x2v __attribute__((ext_vector_type(2)));
        const int col0 = u.pn * BM + wc * 32 + 4 * fq;
#pragma unroll
        for (int ai = 0; ai < 2; ++ai)
#pragma unroll
            for (int m = 0; m < 4; ++m) { const int r = u.pm * BM + ai * HALF + wr * 64 + m * 16 + fr; const size_t off = (size_t)r * 1024 + col0; float ss = 0.f;
#pragma unroll
                for (int bj = 0; bj < 2; ++bj)
#pragma unroll
                    for (int n = 0; n < 2; ++n) { const f32x4 bs = *(const f32x4*)(base + off + bj * HALF + n * 16); const f32x4 o = bs + acc[ai][bj][m][n];
                        *(f32x4*)(out + off + bj * HALF + n * 16) = o; ss += (o[0] * o[0] + o[1] * o[1]) + (o[2] * o[2] + o[3] * o[3]);
                        u32x2v w; w.x = cvt_pk_bf16(o[0], o[1]); w.y = cvt_pk_bf16(o[2], o[3]); *(u32x2v*)(xb + off + bj * HALF + n * 16) = w; }
                ss += __shfl_xor(ss, 16); ss += __shfl_xor(ss, 32);
                if (fq == 0) atomicAdd(rowss + r, ss);
                if (m & 1) asm volatile("" ::: "memory"); }
    }
};

template <class Epi, class Sched, bool ALIGN_EPI = false, bool SP2 = false>
__device__ __forceinline__ void gemm_phase(PG8_LAS unsigned char* lds, const Gemm g, const Sched& S, const Epi& E) {
    int tid_l = threadIdx.x; asm volatile("" : "+v"(tid_l));
    const int tid = tid_l, wid = __builtin_amdgcn_readfirstlane(tid >> 6), lane = tid & 63, wr = wid >> 2, wc = wid & 3, fr = lane & 15, fq = lane >> 4;
    const int K = g.K, nt = K / BK;
    unsigned voffA[2], voffB[2];
#pragma unroll
    for (int i = 0; i < 2; ++i) { int R, C; stage_rc(tid * 16 + i * 8192, R, C); const int Rb = Epi::PERM ? ((R & ~31) + perm32(R & 31)) : R;
        voffA[i] = (unsigned)(R * K + C) * 2u; voffB[i] = (unsigned)(Rb * K + C) * 2u; }
    const size_t kstep = (size_t)(BK * 2);
    const size_t hstep = (size_t)HALF * K * 2;
    const size_t tstep = 2 * hstep;
    const unsigned ldsw = (unsigned)wid * 1024u;
    const int aoff = lds_byte(wr * 64 + fr, fq * 8), boff = lds_byte(wc * 32 + fr, fq * 8);
#define PG8_SA(b, h) (((b) * 2 + (h)) * HTB)
#define PG8_SB(b, h) ((4 + (b) * 2 + (h)) * HTB)
#define PG8_STAGE(bufoff, gbase, voff) do { _Pragma("unroll") for (int _i = 0; _i < 2; ++_i) \
        __builtin_amdgcn_global_load_lds((const unsigned*)((const char*)(gbase) + (voff)[_i]), (PG8_LAS unsigned*)(lds + (bufoff) + ldsw + _i * 8192), 16, 0, 0); } while (0)
#define PG8_LDA(dst, b, h) do { _Pragma("unroll") for (int m = 0; m < 4; ++m) _Pragma("unroll") for (int k = 0; k < 2; ++k) dst[m][k] = *(const PG8_LAS bf16x8*)(lds + PG8_SA(b, h) + aoff + m * 2048 + k * 1024); } while (0)
#define PG8_LDB(dst, b, h) do { _Pragma("unroll") for (int n = 0; n < 2; ++n) _Pragma("unroll") for (int k = 0; k < 2; ++k) dst[n][k] = *(const PG8_LAS bf16x8*)(lds + PG8_SB(b, h) + boff + n * 2048 + k * 1024); } while (0)
#define PG8_MMA(ai, bj, At, Bt) do { __builtin_amdgcn_s_setprio(1); _Pragma("unroll") for (int m = 0; m < 4; ++m) _Pragma("unroll") for (int n = 0; n < 2; ++n) _Pragma("unroll") for (int k = 0; k < 2; ++k) \
        acc[ai][bj][m][n] = __builtin_amdgcn_mfma_f32_16x16x32_bf16(Bt[n][k], At[m][k], acc[ai][bj][m][n], 0, 0, 0); __builtin_amdgcn_s_setprio(0); } while (0)
#define PG8_WAIT_V(n) asm volatile("s_waitcnt vmcnt(" #n ")" ::: "memory")
#define PG8_WAIT_L(n) asm volatile("s_waitcnt lgkmcnt(" #n ")" ::: "memory")
#define PG8_BAR __builtin_amdgcn_s_barrier()
#define PG8_SCHED __builtin_amdgcn_sched_barrier(0)
    Unit cur, nxt; int ui = 0;
    if (!S.next(0, cur)) return;
    f32x4 acc[2][2][4][2];
#pragma unroll
    for (int a = 0; a < 2; ++a)
#pragma unroll
        for (int b = 0; b < 2; ++b)
#pragma unroll
            for (int m = 0; m < 4; ++m)
#pragma unroll
                for (int n = 0; n < 2; ++n) acc[a][b][m][n] = (f32x4){0.f, 0.f, 0.f, 0.f};
    bf16x8 At[4][2], B0[2][2], B1[2][2];
    const char* cA = (const char*)g.A + (size_t)cur.pm * tstep; const char* cB = (const char*)g.Bt + (size_t)cur.pn * tstep;
    S.a_ready(cur);
    if constexpr (SP2) {
        PG8_STAGE(PG8_SB(0, 0), cB, voffB); PG8_STAGE(PG8_SB(0, 1), cB + hstep, voffB); PG8_STAGE(PG8_SA(0, 0), cA, voffA); PG8_STAGE(PG8_SA(0, 1), cA + hstep, voffA);
        if (wr == 1) PG8_BAR;
        PG8_WAIT_V(2); PG8_BAR;
        PG8_STAGE(PG8_SB(1, 0), cB + kstep, voffB); PG8_STAGE(PG8_SA(1, 0), cA + kstep, voffA); PG8_STAGE(PG8_SB(1, 1), cB + hstep + kstep, voffB);
        PG8_WAIT_V(6); PG8_BAR;
    } else {
        PG8_STAGE(PG8_SB(0, 0), cB, voffB); PG8_STAGE(PG8_SA(0, 0), cA, voffA); PG8_STAGE(PG8_SB(0, 1), cB + hstep, voffB); PG8_STAGE(PG8_SA(0, 1), cA + hstep, voffA);
        if (wr == 1) PG8_BAR;
        PG8_WAIT_V(4); PG8_BAR;
        PG8_STAGE(PG8_SB(1, 0), cB + kstep, voffB); PG8_STAGE(PG8_SA(1, 0), cA + kstep, voffA); PG8_STAGE(PG8_SB(1, 1), cB + hstep + kstep, voffB);
        PG8_WAIT_V(6); PG8_BAR;
    }
    for (;;) {
        const bool has_next = S.next(ui + 1, nxt);
        const char* nA = has_next ? (const char*)g.A + (size_t)nxt.pm * tstep : cA; const char* nB = has_next ? (const char*)g.Bt + (size_t)nxt.pn * tstep : cB;
        for (int t = 0; t < nt; t += 2) {
            const bool last = (t == nt - 2);
            const char* a1 = cA + (size_t)(t + 1) * kstep;
            const char* a2 = last ? nA : cA + (size_t)(t + 2) * kstep; const char* b2 = last ? nB : cB + (size_t)(t + 2) * kstep;
            const char* a3 = a2 + kstep; const char* b3 = b2 + kstep;
            if (last && has_next) S.a_ready(nxt);
            if constexpr (SP2) {
            PG8_LDB(B0, 0, 0); PG8_LDB(B1, 0, 1); PG8_SCHED; PG8_LDA(At, 0, 0); PG8_STAGE(PG8_SA(1, 1), a1 + hstep, voffA);
            PG8_WAIT_V(8); PG8_WAIT_L(0); PG8_BAR; PG8_MMA(0, 0, At, B0); PG8_MMA(0, 1, At, B1); PG8_BAR; PG8_SCHED;
            PG8_LDA(At, 0, 1); PG8_STAGE(PG8_SB(0, 0), b2, voffB); PG8_STAGE(PG8_SB(0, 1), b2 + hstep, voffB); PG8_STAGE(PG8_SA(0, 0), a2, voffA);
            PG8_WAIT_V(8); PG8_WAIT_L(0); PG8_BAR; PG8_MMA(1, 0, At, B0); PG8_MMA(1, 1, At, B1); PG8_BAR; PG8_SCHED;
            PG8_LDB(B0, 1, 0); PG8_LDB(B1, 1, 1); PG8_SCHED; PG8_LDA(At, 1, 0); PG8_STAGE(PG8_SA(0, 1), a2 + hstep, voffA);
            PG8_WAIT_V(8); PG8_WAIT_L(0); PG8_BAR; PG8_MMA(0, 0, At, B0); PG8_MMA(0, 1, At, B1); PG8_BAR; PG8_SCHED;
            PG8_LDA(At, 1, 1); PG8_STAGE(PG8_SB(1, 0), b3, voffB); PG8_STAGE(PG8_SB(1, 1), b3 + hstep, voffB); PG8_STAGE(PG8_SA(1, 0), a3, voffA);
            PG8_WAIT_V(8); PG8_WAIT_L(0); PG8_BAR; PG8_MMA(1, 0, At, B0); PG8_MMA(1, 1, At, B1); PG8_BAR; PG8_SCHED;
            } else {
            PG8_LDB(B0, 0, 0); PG8_SCHED; PG8_LDA(At, 0, 0); PG8_STAGE(PG8_SA(1, 1), a1 + hstep, voffA);
            PG8_WAIT_L(8); PG8_BAR; PG8_WAIT_L(0); PG8_MMA(0, 0, At, B0); PG8_BAR; PG8_SCHED;
            PG8_LDB(B1, 0, 1); PG8_STAGE(PG8_SB(0, 0), b2, voffB);
            PG8_BAR; PG8_WAIT_L(0); PG8_MMA(0, 1, At, B1); PG8_BAR;
            PG8_LDA(At, 0, 1); PG8_STAGE(PG8_SA(0, 0), a2, voffA);
            PG8_BAR; PG8_WAIT_L(0); PG8_MMA(1, 0, At, B0); PG8_BAR; PG8_SCHED;
            PG8_STAGE(PG8_SB(0, 1), b2 + hstep, voffB);
            PG8_WAIT_V(6); PG8_BAR; PG8_MMA(1, 1, At, B1); PG8_BAR;
            PG8_LDB(B0, 1, 0); PG8_SCHED; PG8_LDA(At, 1, 0); PG8_STAGE(PG8_SA(0, 1), a2 + hstep, voffA);
            PG8_WAIT_L(8); PG8_BAR; PG8_WAIT_L(0); PG8_MMA(0, 0, At, B0); PG8_BAR; PG8_SCHED;
            PG8_LDB(B1, 1, 1); PG8_STAGE(PG8_SB(1, 0), b3, voffB);
            PG8_BAR; PG8_WAIT_L(0); PG8_MMA(0, 1, At, B1); PG8_BAR;
            PG8_LDA(At, 1, 1); PG8_STAGE(PG8_SA(1, 0), a3, voffA);
            PG8_BAR; PG8_WAIT_L(0); PG8_MMA(1, 0, At, B0); PG8_BAR; PG8_SCHED;
            PG8_STAGE(PG8_SB(1, 1), b3 + hstep, voffB);
            PG8_WAIT_V(6); PG8_BAR; PG8_MMA(1, 1, At, B1); PG8_BAR;
            }
        }
        if constexpr (ALIGN_EPI) { if (wr == 0) PG8_BAR; }
        if constexpr (!Epi::AFTER_DRAIN) { E(acc, cur, wr, wc, fr, fq); S.done(cur); }
        if (!has_next) break;
#pragma unroll
        for (int a = 0; a < 2; ++a)
#pragma unroll
            for (int b = 0; b < 2; ++b)
#pragma unroll
                for (int m = 0; m < 4; ++m)
#pragma unroll
                    for (int n = 0; n < 2; ++n) acc[a][b][m][n] = (f32x4){0.f, 0.f, 0.f, 0.f};
        cur = nxt; cA = nA; cB = nB; ++ui;
        if constexpr (ALIGN_EPI) { if (wr == 1) PG8_BAR; }
    }
    PG8_WAIT_V(0);
    if constexpr (!ALIGN_EPI) { if (wr == 0) PG8_BAR; }
    PG8_BAR;
    if constexpr (Epi::AFTER_DRAIN) { E.fused(acc, cur, wr, wc, fr, fq, lds, wid, lane); S.done(cur); }
#undef PG8_SA
#undef PG8_SB
#undef PG8_STAGE
#undef PG8_LDA
#undef PG8_LDB
#undef PG8_MMA
#undef PG8_WAIT_V
#undef PG8_WAIT_L
#undef PG8_BAR
#undef PG8_SCHED
}
}
#define PG8_SP2 true
#define PG8_ALIGN true
namespace attn_body {
using bf16=__hip_bfloat16;
using bf16x8=__attribute__((ext_vector_type(8)))short;
using s16x4=__attribute__((ext_vector_type(4)))short;
using f32x16=__attribute__((ext_vector_type(16)))float;
using u32x4=__attribute__((ext_vector_type(4)))unsigned;
constexpr int BATCH=2,NHEAD=8,SEQ=8192,D=64,DM=NHEAD*D,OPITCH=1024,KPAD=128,LKV=SEQ+KPAD;
constexpr int NW=8,QBLK=32,QB=QBLK*NW,KVBLK=64,NQB=SEQ/QB;
constexpr int ATTN_PITCH=DM, ATTN_UNIT_ROWS=QB;
__device__ __forceinline__ int crow(int r,int hi){return (r&3)+8*(r>>2)+4*hi;}
#define SBAR() __builtin_amdgcn_sched_barrier(0)
__device__ __forceinline__ void cmask(f32x16&p0,f32x16&p1,int jb,int qrel,int hi){
  const float NEG=-INFINITY; int kb=64*jb+4*hi;
  #pragma unroll
  for(int r=0;r<16;++r){int kv=kb+(r&3)+8*(r>>2); if(kv>qrel)p0[r]=NEG; if(kv+32>qrel)p1[r]=NEG;}
}

constexpr int NSLOT=3, SLOTB=8192;
constexpr int LDS_K=0, LDS_V=NSLOT*SLOTB, LDS_WS=2*NSLOT*SLOTB, LDS_OST=LDS_WS+NW*64*4, LDS_BYTES=LDS_OST+NW*4096, LDS_TAB=LDS_BYTES, LDS_TOTAL=LDS_TAB+LKV*4;
constexpr float C2=0.125f*1.4426950408889634f;
__device__ __forceinline__ void glds16(const void*gsrc,unsigned lds_dst){unsigned keep;
  asm volatile("s_mov_b32 %0, m0\n\ts_mov_b32 m0, %2\n\ts_nop 0\n\tglobal_load_lds_dwordx4 %1, off\n\ts_mov_b32 m0, %0":"=&s"(keep):"v"(gsrc),"s"(lds_dst):"memory");}
__device__ __forceinline__ float max3f(float a,float b,float c){float r;asm("v_max3_f32 %0, %1, %2, %3":"=v"(r):"v"(a),"v"(b),"v"(c));return r;}
__device__ __forceinline__ float max2f(float a,float b){float r;asm("v_max_f32_e32 %0, %1, %2":"=v"(r):"v"(a),"v"(b));return r;}
__device__ __forceinline__ float fadd_s(float a,float b){float r;asm("v_add_f32_e32 %0, %1, %2":"=v"(r):"v"(a),"v"(b));return r;}
__device__ __forceinline__ float fsub_s(float a,float b){float r;asm("v_sub_f32_e32 %0, %1, %2":"=v"(r):"v"(a),"v"(b));return r;}
typedef float f32x2_t __attribute__((ext_vector_type(2))); typedef __bf16 bf16x2_t __attribute__((ext_vector_type(2)));
__device__ __forceinline__ unsigned cvtpk_s(float lo,float hi){f32x2_t v={lo,hi};bf16x2_t b=__builtin_convertvector(v,bf16x2_t);return __builtin_bit_cast(unsigned,b);}
#define WAIT_BAR(N) asm volatile("s_waitcnt vmcnt(" #N ") lgkmcnt(0)\n\ts_barrier":::"memory")
__device__ __forceinline__ void split3(float x,unsigned&a,unsigned&b,unsigned&c){
  a=cvtpk_s(x,0.f)&0xffffu; const float r1=x-__uint_as_float(a<<16);
  b=cvtpk_s(r1,0.f)&0xffffu; const float r2=r1-__uint_as_float(b<<16);
  c=cvtpk_s(r2,0.f)&0xffffu; }
__device__ __forceinline__ bf16x8 mkkb(float x){ unsigned a,b,c; split3(x,a,b,c); u32x4 w; w.x=a|(b<<16); w.y=c|0x3F800000u; w.z=0x3F803F80u; w.w=0u; return __builtin_bit_cast(bf16x8,w); }
__device__ __forceinline__ bf16x8 mkqb(float mh,int hi){ unsigned a,b,c; split3(-mh,a,b,c); u32x4 w; w.x=0x3F803F80u; w.y=0x3F80u|(a<<16); w.z=b|(c<<16); w.w=0u; if(hi){w.x=0u;w.y=0u;w.z=0u;} return __builtin_bit_cast(bf16x8,w); }
typedef const __attribute__((address_space(3))) float* lds_fptr;

__device__ __forceinline__ void qkt(f32x16&p0,f32x16&p1,const char*Kslot,const bf16x8*qr,bf16x8 kb0,bf16x8 kb1,bf16x8 qb,int r32,int hi){
  const char*kb=Kslot+hi*1024+r32*16;
  { const f32x16 z=f32x16{}; p0=__builtin_amdgcn_mfma_f32_32x32x16_bf16(kb0,qb,z,0,0,0); p1=__builtin_amdgcn_mfma_f32_32x32x16_bf16(kb1,qb,z,0,0,0); }
  #pragma unroll
  for(int d0=0;d0<4;++d0){
    const bf16x8 b0=*reinterpret_cast<const bf16x8*>(kb+d0*2048);
    const bf16x8 b1=*reinterpret_cast<const bf16x8*>(kb+d0*2048+512);
    p0=__builtin_amdgcn_mfma_f32_32x32x16_bf16(b0,qr[d0],p0,0,0,0);p1=__builtin_amdgcn_mfma_f32_32x32x16_bf16(b1,qr[d0],p1,0,0,0);}
}
typedef __attribute__((address_space(3))) const char* lds_cptr;
typedef short v4i16_t __attribute__((ext_vector_type(4)));
__device__ __forceinline__ void kload8(bf16x8*kf,lds_cptr kp){
  kf[0]=*(const __attribute__((address_space(3))) bf16x8*)(kp);      kf[1]=*(const __attribute__((address_space(3))) bf16x8*)(kp+512);
  kf[2]=*(const __attribute__((address_space(3))) bf16x8*)(kp+2048); kf[3]=*(const __attribute__((address_space(3))) bf16x8*)(kp+2560);
  kf[4]=*(const __attribute__((address_space(3))) bf16x8*)(kp+4096); kf[5]=*(const __attribute__((address_space(3))) bf16x8*)(kp+4608);
  kf[6]=*(const __attribute__((address_space(3))) bf16x8*)(kp+6144); kf[7]=*(const __attribute__((address_space(3))) bf16x8*)(kp+6656);
}
__device__ __forceinline__ void kload2(bf16x8*kf,lds_cptr kp,int j){ kf[2*j]=*(const __attribute__((address_space(3))) bf16x8*)(kp+j*2048); kf[2*j+1]=*(const __attribute__((address_space(3))) bf16x8*)(kp+j*2048+512); }
__device__ __forceinline__ s16x4 vtr(lds_cptr p){ return __builtin_bit_cast(s16x4,__builtin_amdgcn_ds_read_tr16_b64_v4i16((__attribute__((address_space(3))) v4i16_t*)p)); }
__device__ __forceinline__ float rowmax(const f32x16&p0,const f32x16&p1){
  float a=max3f(p0[0],p0[1],p1[0]),b=max3f(p0[2],p0[3],p1[1]);a=max3f(a,p1[2],p1[3]);
  #pragma unroll
  for(int r=4;r<16;r+=4){a=max3f(a,p0[r],p0[r+1]);b=max3f(b,p0[r+2],p0[r+3]);a=max3f(a,p1[r],p1[r+1]);b=max3f(b,p1[r+2],p1[r+3]);}
  const float m=max2f(a,b);
  auto rr=__builtin_amdgcn_permlane32_swap(__float_as_uint(m),__float_as_uint(m),false,false);
  return max2f(__uint_as_float(rr[0]),__uint_as_float(rr[1]));
}
__device__ __forceinline__ void pv(f32x16*o,int vb,bf16x8 pa0,bf16x8 pa1,bf16x8 pa2,bf16x8 pa3){
  #pragma unroll
  for(int d0=0;d0<2;++d0){s16x4 lo[4],hi[4];
    #pragma unroll
    for(int ks=0;ks<4;++ks){
      asm volatile("ds_read_b64_tr_b16 %0,%1 offset:%c2":"=&v"(lo[ks]):"v"(vb),"i"(d0*4096+ks*1024):"memory");
      asm volatile("ds_read_b64_tr_b16 %0,%1 offset:%c2":"=&v"(hi[ks]):"v"(vb),"i"(d0*4096+ks*1024+512):"memory");}
    asm volatile("s_waitcnt lgkmcnt(0)":::"memory");SBAR();
    #define PK(k) (bf16x8){lo[k][0],lo[k][1],lo[k][2],lo[k][3],hi[k][0],hi[k][1],hi[k][2],hi[k][3]}
    o[d0]=__builtin_amdgcn_mfma_f32_32x32x16_bf16(pa0,PK(0),o[d0],0,0,0);
    o[d0]=__builtin_amdgcn_mfma_f32_32x32x16_bf16(pa1,PK(1),o[d0],0,0,0);
    o[d0]=__builtin_amdgcn_mfma_f32_32x32x16_bf16(pa2,PK(2),o[d0],0,0,0);
    o[d0]=__builtin_amdgcn_mfma_f32_32x32x16_bf16(pa3,PK(3),o[d0],0,0,0);
    #undef PK
  }
}

#ifndef ATTN_STORE16
#define ATTN_STORE16(p,v) (*(u32x4*)(p)=(v))
#endif
template<int THRL> __device__ __forceinline__ void attn_unit(int b,int h,int qb,const bf16*Q,const bf16*__restrict__ K,const bf16*__restrict__ V,bf16*O,char*shm,lds_fptr xt){
  int tid_l=threadIdx.x; asm volatile("":"+v"(tid_l)); const int tid=tid_l,lane=tid&63,r32=lane&31,hi=lane>>5; const int wid=__builtin_amdgcn_readfirstlane(tid>>6);
  const long rowbase=(long)b*SEQ, kvbase=(long)b*LKV; const int q0=qb*QB;
  const bf16*Qw=Q+(rowbase+q0+wid*QBLK)*DM+h*D;
  const bf16*Kh=K+kvbase*DM+h*D,*Vh=V+kvbase*DM+h*D;
  const unsigned lds0=(unsigned)(uintptr_t)shm;
  float*wsf=(float*)(shm+LDS_WS)+wid*64;
  const bf16*ksrc=Kh+(long)lane*DM+wid*8;
  const bf16*vsrc=Vh+(long)(16*(wid&3)+(lane>>2))*DM+(wid>>2)*32+(lane&3)*8;
  const unsigned kdst=lds0+LDS_K+wid*1024, vdst=lds0+LDS_V+wid*1024;
  #define DMA_K(t,slot) glds16(ksrc+(long)(t)*KVBLK*DM,(unsigned)__builtin_amdgcn_readfirstlane(kdst+(slot)))
  #define DMA_V(t,slot) glds16(vsrc+(long)(t)*KVBLK*DM,(unsigned)__builtin_amdgcn_readfirstlane(vdst+(slot)))
  const int vb0=(int)(lds0+LDS_V)+((lane>>4)&1)*32+(lane&3)*8+(4*hi+((lane&15)>>2))*64;
  const char*Kbase=shm+LDS_K; bf16x8 kf[8];
  const lds_cptr shm3=(lds_cptr)shm; const lds_cptr kp0=shm3+LDS_K+hi*1024+r32*16; const lds_cptr vp0=shm3+LDS_V+((lane>>4)&1)*32+(lane&3)*8+(4*hi+((lane&15)>>2))*64;
  const int NT=(q0+QB+KPAD)/KVBLK;
  DMA_K(0,0);DMA_V(0,0);DMA_K(1,SLOTB);
  bf16x8 qr[4];
  #pragma unroll
  for(int d0=0;d0<4;++d0)qr[d0]=*reinterpret_cast<const bf16x8*>(&Qw[(long)r32*DM+d0*16+hi*8]);
  float mhat=0.f,l_reg=0.f;f32x16 o[2];o[0]=f32x16{};o[1]=f32x16{};bf16x8 qbf=mkqb(0.f,hi); const float xbase=xt[KPAD+q0]; float xn0,xn1;
  const int qrel=wid*QBLK+r32;
  #define CMASK(P0,P1,t) do{int jb_=(t)-(NT-4); if(jb_>=0)cmask(P0,P1,jb_,qrel,hi);}while(0)
  bool resc=false;
  #define START(P0,P1) do{ const float rm=rowmax(P0,P1); resc=false; \
    { const float dl=rm; mhat=fadd_s(mhat,dl); \
      _Pragma("unroll") for(int r=0;r<16;++r){P0[r]=fsub_s(P0[r],dl);P1[r]=fsub_s(P1[r],dl);} \
      qbf=mkqb(mhat,hi); } \
    _Pragma("unroll") for(int r=0;r<16;++r)P0[r]=__builtin_amdgcn_exp2f(P0[r]); }while(0)
  #define RESC() do{ if(resc){ asm volatile("s_waitcnt lgkmcnt(0)":::"memory"); \
      _Pragma("unroll") for(int d_=0;d_<2;++d_) _Pragma("unroll") for(int r=0;r<16;++r)o[d_][r]*=wsf[crow(r,hi)]; } }while(0)
  f32x16 pA0,pA1,pB0,pB1;
  int sl_prev=0,sl_cur=0,sl_next=SLOTB;
  #define ROT() do{sl_prev=sl_cur;sl_cur=sl_next;sl_next=(sl_next==(NSLOT-1)*SLOTB)?0:sl_next+SLOTB;}while(0)
  DMA_K(2,2*SLOTB);
  WAIT_BAR(3);
  { const float xa_=xt[r32]-xbase, xb_=xt[32+r32]-xbase; qkt(pA0,pA1,Kbase,qr,mkkb(xa_),mkkb(xb_),qbf,r32,hi); } asm volatile("s_nop 15\n\ts_nop 7":"+v"(pA0),"+v"(pA1));CMASK(pA0,pA1,0);
  START(pA0,pA1);
  _Pragma("unroll") for(int r=0;r<16;++r)pA1[r]=__builtin_amdgcn_exp2f(pA1[r]);
  WAIT_BAR(0);
  DMA_K(3,0);DMA_V(1,SLOTB);
  ROT();
  kload8(kf,kp0+sl_cur); xn0=xt[64+r32]-xbase; xn1=xt[96+r32]-xbase;
  WAIT_BAR(2);
  s16x4 vlo[8],vhi[8]; u32x4 pw0,pw1,pw2,pw3;
  #define PKW(P,B) cvtpk_s(P[B],P[B+1])
  #define PAF(k) __builtin_bit_cast(bf16x8,pw##k)
  #define VFR(i) (bf16x8){vlo[i][0],vlo[i][1],vlo[i][2],vlo[i][3],vhi[i][0],vhi[i][1],vhi[i][2],vhi[i][3]}
  #define PIN(x) asm volatile("":"+v"(x))
  #define MX3(a,b,c) __builtin_fmaxf(__builtin_fmaxf((a),(b)),(c))
  #define GAPA(MF,A0,A1,A2,A3,W0,W1,PW) do{ MF; sacc+=A0; sacc+=A1; sacc+=A2; sacc+=A3; PIN(sacc); W0; W1; PIN(PW); SBAR(); }while(0)
  #define EX(v) __builtin_amdgcn_exp2f(v)
  #define GAPB(MF,X,B) do{ MF; X[B]=EX(X[B]); X[B+1]=EX(X[B+1]); X[B+2]=EX(X[B+2]); X[B+3]=EX(X[B+3]); PIN(X); SBAR(); }while(0)
  #define VRD(i) do{ vlo[i]=vtr(vp_+(((i)>>2)*4096+((i)&3)*1024)); vhi[i]=vtr(vp_+(((i)>>2)*4096+((i)&3)*1024+512)); }while(0)
  #define KRD(G,j) do{ if(G){ kload2(kf,kp0+sl_next,j); SBAR(); } }while(0)
  #define STEP(C0,C1,P0,P1,t,GK,GV,GL) do{ SBAR(); \
    const lds_cptr vp_=vp0+sl_prev; \
    VRD(0); SBAR(); float sacc=(P0[0]+P0[1]); \
    { const f32x16 z_=f32x16{}; const bf16x8 kb0_=mkkb(xn0),kb1_=mkkb(xn1); C0=__builtin_amdgcn_mfma_f32_32x32x16_bf16(kb0_,qbf,z_,0,0,0); C1=__builtin_amdgcn_mfma_f32_32x32x16_bf16(kb1_,qbf,z_,0,0,0); } SBAR(); \
    GAPA(C0=__builtin_amdgcn_mfma_f32_32x32x16_bf16(kf[0],qr[0],C0,0,0,0), P0[2],P0[3],P0[4],P0[5],     pw0[0]=PKW(P0,0), pw0[1]=PKW(P0,2), pw0); \
    VRD(4); SBAR(); GAPA(C1=__builtin_amdgcn_mfma_f32_32x32x16_bf16(kf[1],qr[0],C1,0,0,0), P0[6],P0[7],P0[8],P0[9],     pw0[2]=PKW(P0,4), pw0[3]=PKW(P0,6), pw0); \
    VRD(1); SBAR(); GAPA(C0=__builtin_amdgcn_mfma_f32_32x32x16_bf16(kf[2],qr[1],C0,0,0,0),   P0[10],P0[11],P0[12],P0[13], pw1[0]=PKW(P0,8), pw1[1]=PKW(P0,10), pw1); \
    VRD(5); SBAR(); GAPA(C1=__builtin_amdgcn_mfma_f32_32x32x16_bf16(kf[3],qr[1],C1,0,0,0),   P0[14],P0[15],P1[0],P1[1],   pw1[2]=PKW(P0,12),pw1[3]=PKW(P0,14), pw1); \
    VRD(2); SBAR(); GAPA(C0=__builtin_amdgcn_mfma_f32_32x32x16_bf16(kf[4],qr[2],C0,0,0,0),   P1[2],P1[3],P1[4],P1[5],     pw2[0]=PKW(P1,0), pw2[1]=PKW(P1,2), pw2); \
    VRD(6); SBAR(); GAPA(C1=__builtin_amdgcn_mfma_f32_32x32x16_bf16(kf[5],qr[2],C1,0,0,0),   P1[6],P1[7],P1[8],P1[9],     pw2[2]=PKW(P1,4), pw2[3]=PKW(P1,6), pw2); \
    VRD(3); SBAR(); GAPA(C0=__builtin_amdgcn_mfma_f32_32x32x16_bf16(kf[6],qr[3],C0,0,0,0),   P1[10],P1[11],P1[12],P1[13], pw3[0]=PKW(P1,8), pw3[1]=PKW(P1,10), pw3); \
    VRD(7); SBAR(); GAPA(C1=__builtin_amdgcn_mfma_f32_32x32x16_bf16(kf[7],qr[3],C1,0,0,0),   P1[14],P1[15],0.f,0.f,       pw3[2]=PKW(P1,12),pw3[3]=PKW(P1,14), pw3); \
    l_reg+=sacc; \
    if(GK){DMA_K((t)+3,sl_cur);} if(GV){DMA_V((t)+1,sl_next);} \
    CMASK(C0,C1,t); \
    { float a=MX3(C0[0],C0[1],C1[0]),b=MX3(C0[2],C0[3],C1[1]); a=MX3(a,C1[2],C1[3]); \
      _Pragma("unroll") for(int r=4;r<16;r+=4){a=MX3(a,C0[r],C0[r+1]);b=MX3(b,C0[r+2],C0[r+3]);a=MX3(a,C1[r],C1[r+1]);b=MX3(b,C1[r+2],C1[r+3]);} \
      float rm=__builtin_fmaxf(a,b); { auto rr=__builtin_amdgcn_permlane32_swap(__float_as_uint(rm),__float_as_uint(rm),false,false); rm=__builtin_fmaxf(__uint_as_float(rr[0]),__uint_as_float(rr[1])); } \
      resc=false; \
      if(__builtin_expect(__any(rm>(float)THRL),0)){ const float dl=__builtin_fmaxf(rm,0.f); mhat+=dl; \
        _Pragma("unroll") for(int r=0;r<16;++r){C0[r]-=dl;C1[r]-=dl;} \
        qbf=mkqb(mhat,hi); \
        const float f=__builtin_amdgcn_exp2f(-dl); l_reg*=f; if(hi==0)wsf[r32]=f; resc=true; } } \
    SBAR(); \
    GAPB(o[0]=__builtin_amdgcn_mfma_f32_32x32x16_bf16(PAF(0),VFR(0),o[0],0,0,0), C0,0); \
    GAPB(o[1]=__builtin_amdgcn_mfma_f32_32x32x16_bf16(PAF(0),VFR(4),o[1],0,0,0), C0,4); \
    if(GL){ xn0=xt[((t)+1)*64+r32]-xbase; xn1=xt[((t)+1)*64+32+r32]-xbase; } KRD(GL,0); GAPB(o[0]=__builtin_amdgcn_mfma_f32_32x32x16_bf16(PAF(1),VFR(1),o[0],0,0,0), C0,8); \
    KRD(GL,1); GAPB(o[1]=__builtin_amdgcn_mfma_f32_32x32x16_bf16(PAF(1),VFR(5),o[1],0,0,0), C0,12); \
    KRD(GL,2); GAPB(o[0]=__builtin_amdgcn_mfma_f32_32x32x16_bf16(PAF(2),VFR(2),o[0],0,0,0), C1,0); \
    KRD(GL,3); GAPB(o[1]=__builtin_amdgcn_mfma_f32_32x32x16_bf16(PAF(2),VFR(6),o[1],0,0,0), C1,4); \
    GAPB(o[0]=__builtin_amdgcn_mfma_f32_32x32x16_bf16(PAF(3),VFR(3),o[0],0,0,0), C1,8); \
    GAPB(o[1]=__builtin_amdgcn_mfma_f32_32x32x16_bf16(PAF(3),VFR(7),o[1],0,0,0), C1,12); \
    }while(0)
  int t=1;
  #undef CMASK
  #define CMASK(P0,P1,t) do{}while(0)
  for(;t+5<NT;t+=2){
    STEP(pB0,pB1,pA0,pA1,t,true,true,true);     WAIT_BAR(2); RESC(); ROT();
    STEP(pA0,pA1,pB0,pB1,t+1,true,true,true);   WAIT_BAR(2); RESC(); ROT();
  }
  #undef CMASK
  #define CMASK(P0,P1,t) do{int jb_=(t)-(NT-4); if(jb_>=0)cmask(P0,P1,jb_,qrel,hi);}while(0)
  #define ENDW(tt) do{ if((tt)+3<NT){WAIT_BAR(2);} else if((tt)+2<NT){WAIT_BAR(1);} else {WAIT_BAR(0);} }while(0)
  for(;t+1<NT;t+=2){
    STEP(pB0,pB1,pA0,pA1,t,(t+3<NT),(t+1<NT),(t+1<NT));       ENDW(t);   RESC(); ROT();
    STEP(pA0,pA1,pB0,pB1,t+1,(t+4<NT),(t+2<NT),(t+2<NT));     ENDW(t+1); RESC(); ROT();
  }
  STEP(pB0,pB1,pA0,pA1,NT-1,false,false,false); RESC();
  { float sacc=pB0[0]+pB0[1]; _Pragma("unroll") for(int r=2;r<16;++r)sacc+=pB0[r]; _Pragma("unroll") for(int r=0;r<16;++r)sacc+=pB1[r]; l_reg+=sacc;
    pw0=(u32x4){PKW(pB0,0),PKW(pB0,2),PKW(pB0,4),PKW(pB0,6)};pw1=(u32x4){PKW(pB0,8),PKW(pB0,10),PKW(pB0,12),PKW(pB0,14)};pw2=(u32x4){PKW(pB1,0),PKW(pB1,2),PKW(pB1,4),PKW(pB1,6)};pw3=(u32x4){PKW(pB1,8),PKW(pB1,10),PKW(pB1,12),PKW(pB1,14)};
    SBAR(); pv(o,vb0+sl_cur,PAF(0),PAF(1),PAF(2),PAF(3)); }
  #undef PKW
  #undef PAF
  #undef VFR
  #undef PIN
  #undef MX3
  #undef GAPA
  #undef GAPB
  #undef EX
  #undef VRD
  #undef KRD
  #undef STEP
  #undef ENDW
  {auto rr=__builtin_amdgcn_permlane32_swap(__float_as_uint(l_reg),__float_as_uint(l_reg),false,false);l_reg=__uint_as_float(rr[0])+__uint_as_float(rr[1]);}
  if(hi==0)wsf[32+r32]=l_reg;asm volatile("s_waitcnt lgkmcnt(0)":::"memory");
  float rli[16];
  #pragma unroll
  for(int r=0;r<16;++r)rli[r]=__builtin_amdgcn_rcpf(wsf[32+crow(r,hi)]);
  bf16*Ow=O+(rowbase+q0+wid*QBLK)*OPITCH+h*D;
  { bf16*stg=(bf16*)(shm+LDS_OST)+wid*2048;
    #pragma unroll
    for(int r=0;r<16;++r){const int orow=crow(r,hi);
      #pragma unroll
      for(int d0=0;d0<2;++d0)stg[orow*64+d0*32+r32]=__float2bfloat16(o[d0][r]*rli[r]);}
    asm volatile("s_waitcnt lgkmcnt(0)":::"memory");
    #pragma unroll
    for(int i=0;i<4;++i){const int row=i*8+(lane>>3),ch=lane&7; const u32x4 v=*(const u32x4*)(stg+row*64+ch*8); ATTN_STORE16(Ow+(long)row*OPITCH+ch*8,v);} }
  asm volatile("s_waitcnt lgkmcnt(0)\n\ts_barrier":::"memory");
  #undef DMA_K
  #undef DMA_V
  #undef CMASK
  #undef START
  #undef RESC
  #undef ROT
}
constexpr int ATTN_LDS_BYTES=LDS_BYTES;
struct AttnTensors { const bf16* Q; const bf16* K; const bf16* V; bf16* O; };
struct AttnUnit { int bh; int qb; };
struct StaticOrder {
  int vcu;
  __device__ __forceinline__ explicit StaticOrder(int grid,int block):vcu((block%8)*(grid/8)+block/8){}
  __device__ __forceinline__ bool next(int i,AttnUnit&u)const{ if(i>=2)return false; const int s=vcu&15; u.bh=vcu>>4; u.qb=(i==0)?31-s:s; return true; }
  __device__ __forceinline__ void a_ready(const AttnUnit&)const{}
  __device__ __forceinline__ void done(const AttnUnit&)const{}
};
template<class Sched,int THRL=8> __device__ __forceinline__ void attn_phase(char*lds,const AttnTensors&T,const Sched&S,lds_fptr xt){
  AttnUnit u;
  for(int i=0;S.next(i,u);++i){ S.a_ready(u); attn_unit<THRL>(u.bh/NHEAD,u.bh%NHEAD,u.qb,T.Q,T.K,T.V,T.O,lds,xt); S.done(u); }
}
#undef SBAR
#undef WAIT_BAR
}
#define GAS __attribute__((address_space(1)))
#define LAS __attribute__((address_space(3)))
typedef unsigned short bf16;
typedef unsigned v4u __attribute__((ext_vector_type(4)));
typedef float f32x4 __attribute__((ext_vector_type(4)));
typedef short bf16x8 __attribute__((ext_vector_type(8)));
typedef GAS unsigned gu32;
typedef GAS unsigned long long gu64;
#define RLX_AGENT __ATOMIC_RELAXED, __HIP_MEMORY_SCOPE_AGENT
#define LDS_WAIT() asm volatile("s_waitcnt lgkmcnt(0)" ::: "memory")
#define VM_WAIT() asm volatile("s_waitcnt vmcnt(0)" ::: "memory")
__device__ __forceinline__ unsigned long long rt() { return __builtin_amdgcn_s_memrealtime(); }
__device__ __forceinline__ unsigned f2bf(float f) { unsigned u = __builtin_bit_cast(unsigned, f); return (u + 0x7fffu + ((u >> 16) & 1u)) >> 16; }
__device__ __forceinline__ unsigned pk2(float lo, float hi) { return f2bf(lo) | (f2bf(hi) << 16); }

#define XB_TMO      128
#define XB_XCNT(j)  (256  + 64 * (j))
#define XB_XSUB(j)  (1280 + 64 * (j))
#define XB_XGEN(j)  (2304 + 64 * (j))
#define XB_TOP      3328
#define XB_TOPGEN   3392
#define XCD_BAR_WORDS 3456
#define XB_SPIN_CAP (1u << 18)

__device__ __forceinline__ unsigned xb_ld(unsigned* p)              { return __hip_atomic_load(p, __ATOMIC_RELAXED, __HIP_MEMORY_SCOPE_AGENT); }
__device__ __forceinline__ unsigned xb_add(unsigned* p, unsigned v) { return __hip_atomic_fetch_add(p, v, __ATOMIC_RELAXED, __HIP_MEMORY_SCOPE_AGENT); }
__device__ __forceinline__ unsigned xb_xcc_id() { return (unsigned)__builtin_amdgcn_s_getreg((3 << 11) | 20) & 0xFu; }
#define XB_SPIN(cond, bar) do { unsigned _sp = 0; while (cond) { __builtin_amdgcn_s_sleep(1); \
    if ((++_sp & 255u) == 0u) { if (xb_ld(&(bar)[XB_TMO])) break; if (_sp > XB_SPIN_CAP) { atomicAdd(&(bar)[XB_TMO], 1u); break; } } } } while (0)

struct XcdBarrier {
    unsigned* bar; unsigned x;
    volatile LAS unsigned* st;
};

__device__ __forceinline__ XcdBarrier xcd_barrier_post(unsigned* bar, volatile LAS unsigned* st) {
    XcdBarrier b; b.bar = bar; b.x = xb_xcc_id(); b.st = st;
    if (threadIdx.x == 0) (void)xb_add(&bar[XB_XCNT(b.x)], 1u);
    return b;
}
__device__ __forceinline__ void xcd_barrier_complete(unsigned* bar, unsigned x, unsigned& nloc, unsigned& nx) {
    const unsigned G = gridDim.x * gridDim.y * gridDim.z;
    unsigned sum, cnt, mine, sp = 0u;
    for (;;) {
        sum = 0u; cnt = 0u; mine = 0u;
#pragma unroll
        for (unsigned j = 0; j < 16; ++j) { const unsigned c = xb_ld(&bar[XB_XCNT(j)]); sum += c; cnt += (c > 0u) ? 1u : 0u; mine = (j == x) ? c : mine; }
        if (sum == G) break;
        __builtin_amdgcn_s_sleep(1);
        if ((++sp & 255u) == 0u) { if (xb_ld(&bar[XB_TMO])) break; if (sp > XB_SPIN_CAP) { atomicAdd(&bar[XB_TMO], 1u); break; } }
    }
    nloc = mine > 0u ? mine : 1u; nx = cnt > 0u ? cnt : 1u;
}

__device__ __forceinline__ void xcd_barrier(const XcdBarrier& b) {
    asm volatile("s_waitcnt vmcnt(0)" ::: "memory");
    __syncthreads();
    if (threadIdx.x == 0) {
        unsigned* bar = b.bar;
        __builtin_amdgcn_s_waitcnt(0);
        unsigned nloc = b.st[0], nx = b.st[1];
        if (nloc == 0u) { xcd_barrier_complete(bar, b.x, nloc, nx); b.st[0] = nloc; b.st[1] = nx; }
        const unsigned old = xb_add(&bar[XB_XSUB(b.x)], 1u);
        const unsigned gen = old / nloc;
        if (old + 1u == (gen + 1u) * nloc) {
            __builtin_amdgcn_fence(__ATOMIC_RELEASE, "agent");
            asm volatile("s_waitcnt vmcnt(0)" ::: "memory");
            const unsigned og = xb_add(&bar[XB_TOP], 1u);
            const unsigned tg = og / nx;
            if (og + 1u == (tg + 1u) * nx) xb_add(&bar[XB_TOPGEN], 1u);
            else XB_SPIN(xb_ld(&bar[XB_TOPGEN]) == tg, bar);
            __builtin_amdgcn_fence(__ATOMIC_ACQUIRE, "agent");
            xb_add(&bar[XB_XGEN(b.x)], 1u);
            asm volatile("s_waitcnt vmcnt(0)" ::: "memory");
        } else {
            XB_SPIN(xb_ld(&bar[XB_XGEN(b.x)]) == gen, bar);
            __builtin_amdgcn_fence(__ATOMIC_ACQUIRE, "agent");
            asm volatile("s_waitcnt vmcnt(0)" ::: "memory");
        }
    }
    __syncthreads();
}
constexpr int NWAVES = 8;
constexpr int BATCH = 2, SEQ = 8192, D = 1024, NMETA = 16, NH = 8, HD = 64, DA = 512, DC = 256, DSC = 256, FF = 4096, CK = 31, SK = 3, DEPTH = 2;
constexpr int M = BATCH * SEQ;
constexpr int NIN_SRC = 2824, NIN = 2816, PMW = 2832;
constexpr int KPAD = pg8::IN_KPAD, LKV = SEQ + KPAD;
constexpr int CPAD = pg8::IN_CPAD, LCV = SEQ + CPAD;
constexpr float EPS = 1e-6f, LOG2E = 1.4426950408889634f;
constexpr float C2 = 0.125f * LOG2E;
static_assert(KPAD == attn_body::KPAD && LKV == attn_body::LKV, "attention body geometry");

constexpr size_t MiB = 1u << 20, KiB = 1u << 10;
constexpr size_t WS_CTL = 0, CTL_ZERO_BYTES = 1 * MiB;
constexpr int CW_TMO = 0, CW_CODE = 1, CW_BAR = 4096;
constexpr size_t RS_OFF = 64 * KiB;
constexpr size_t RSM_OFF = RS_OFF + 5 * 64 * KiB;
static_assert(RSM_OFF + 5 * 16 * 4 <= CTL_ZERO_BYTES, "ctl");
constexpr size_t WS_WIN = 2 * MiB, SZ_WIN = (size_t)NIN * D * 2;
constexpr size_t WS_WOUT = 13 * MiB, SZ_WOUT = (size_t)D * D * 2;
constexpr size_t WS_W1 = 17 * MiB, SZ_W1 = (size_t)FF * D * 2;
constexpr size_t WS_W2 = 33 * MiB, SZ_W2 = (size_t)D * FF * 2;
constexpr size_t WS_WPW = 49 * MiB, SZ_WPW = (size_t)DC * DC * 2;
constexpr size_t WS_WF = WS_WPW + 256 * KiB, SZ_WF = 16 * D * 2;
constexpr size_t WS_META = 49 * MiB + 512 * KiB;
constexpr size_t MO_PM = 0, MO_XM = 192 * KiB, MO_HM = 224 * KiB, MO_H1M = 288 * KiB, MO_MIXM = 352 * KiB, MO_HIDM = 384 * KiB;
static_assert(16 * PMW * 4 <= 192 * KiB && MO_HIDM + 16 * FF * 2 <= 512 * KiB, "meta map");
constexpr size_t WS_LP = 50 * MiB, WS_TOT = WS_LP + 512 * KiB;
constexpr size_t WS_XB = 51 * MiB;
constexpr size_t WS_Q = 83 * MiB, WS_K = 99 * MiB, WS_V = WS_K + 16 * MiB + 256 * KiB, WS_CB = 132 * MiB, WS_MIX = 173 * MiB;
constexpr size_t CB_STRIDE = (size_t)BATCH * LCV * 256;
constexpr size_t WS_HID = 83 * MiB;
constexpr size_t WS_END = 211 * MiB;
static_assert(WS_WIN + 2 * SZ_WIN <= WS_WOUT && WS_WOUT + 2 * SZ_WOUT <= WS_W1 && WS_W1 + 2 * SZ_W1 <= WS_W2 && WS_W2 + 2 * SZ_W2 <= WS_WPW && WS_WPW + 2 * SZ_WPW <= WS_WF && WS_WF + 2 * SZ_WF <= WS_META, "weights map");
static_assert(WS_Q + (size_t)M * DA * 2 <= WS_K && WS_K + (size_t)BATCH * LKV * DA * 2 <= WS_V && WS_V + (size_t)BATCH * LKV * DA * 2 <= WS_CB && WS_CB + 5 * CB_STRIDE * 2 <= WS_MIX && WS_MIX + (size_t)M * D * 2 <= WS_END &&
              WS_HID + (size_t)M * FF * 2 <= WS_END && WS_XB + (size_t)M * D * 2 <= WS_Q && WS_TOT + 8 * KiB <= WS_XB, "activation map");

constexpr int RING_OFF = 0, RING_BYTES = 131072;
constexpr int LDSCTL_OFF = RING_BYTES, MISC_OFF = LDSCTL_OFF + 320;
constexpr int LDS_BYTES = 147456;
static_assert(attn_body::LDS_TOTAL + 512 <= RING_BYTES, "attention LDS");

__device__ __forceinline__ float wave_sum(float v) {
#pragma unroll
    for (int o = 1; o < 64; o <<= 1) v += __shfl_xor(v, o);
    return v;
}
__device__ __forceinline__ float rstd_of(float ss) { return 1.0f / sqrtf(ss * (1.0f / 1024.0f) + EPS); }
__device__ __forceinline__ float logsig(float x) { return fminf(x, 0.f) - log1pf(__expf(-fabsf(x))); }
__device__ __forceinline__ float sigm(float x) { return 1.0f / (1.0f + __expf(-x)); }
__device__ __forceinline__ float bf2f(unsigned short h) { return __uint_as_float((unsigned)h << 16); }
__device__ __forceinline__ void bf8_to_f(const bf16x8 v, float (&f)[8]) {
#pragma unroll
    for (int i = 0; i < 8; ++i) f[i] = __uint_as_float((unsigned)(unsigned short)v[i] << 16);
}

__device__ __forceinline__ void p0_transpose_item(const float* W, int ldw, int src_col0, const float* gk, bf16* WT, int ldt, int dst_row0, LAS float* scr, int k0, int lane) {
    asm volatile("" : "+v"(lane));
#pragma unroll 8
    for (int i = 0; i < 32; ++i) { const int kk = 2 * i + (lane >> 5); float w = W[(size_t)(k0 + kk) * ldw + src_col0 + (lane & 31)]; if (gk) w *= gk[k0 + kk]; scr[kk * 33 + (lane & 31)] = w; }
    LDS_WAIT(); asm volatile("" ::: "memory");
    const int c = lane & 7;
#pragma unroll
    for (int j = 0; j < 4; ++j) { const int n = (lane >> 3) + 8 * j; const LAS float* s = scr + (8 * c) * 33 + n;
        v4u o; o.x = pk2(s[0 * 33], s[1 * 33]); o.y = pk2(s[2 * 33], s[3 * 33]); o.z = pk2(s[4 * 33], s[5 * 33]); o.w = pk2(s[6 * 33], s[7 * 33]);
        *(GAS v4u*)(WT + (size_t)(dst_row0 + n) * ldt + k0 + 8 * c) = o; }
    LDS_WAIT(); asm volatile("" ::: "memory");
}

template <class Epi> __device__ __forceinline__ void meta_gemm_item(LAS unsigned char* lds, const bf16* A, int lda, const bf16* Bt, int ldb, int ks, const Epi& E, int tid, int wave, int lane) {
    int tid_l = tid; asm volatile("" : "+v"(tid_l)); tid = tid_l; lane = tid & 63;
    f32x4 acc = {0.f, 0.f, 0.f, 0.f};
    const bf16* ap = A + (size_t)(lane & 15) * lda + wave * ks * 32 + 8 * (lane >> 4);
    const bf16* bp = Bt + (size_t)(lane & 15) * ldb + wave * ks * 32 + 8 * (lane >> 4);
    for (int s = 0; s < ks; s += 4) {
        bf16x8 a[4], b[4];
#pragma unroll
        for (int i = 0; i < 4; ++i) { a[i] = *(const GAS bf16x8*)(ap + (s + i) * 32); b[i] = *(const GAS bf16x8*)(bp + (s + i) * 32); }
#pragma unroll
        for (int i = 0; i < 4; ++i) acc = __builtin_amdgcn_mfma_f32_16x16x32_bf16(a[i], b[i], acc, 0, 0, 0);
    }
    LAS float* red = (LAS float*)lds;
#pragma unroll
    for (int r = 0; r < 4; ++r) red[wave * 256 + ((lane >> 4) * 4 + r) * 16 + (lane & 15)] = acc[r];
    __syncthreads();
    if (tid < 256) { float v = 0.f;
#pragma unroll
        for (int w = 0; w < 8; ++w) v += red[w * 256 + tid];
        E(tid >> 4, tid & 15, v); }
    __syncthreads();
}
struct MEpiIn {
    float* PM; bf16* Kb; bf16* Vb; bf16* CB; const float* rssm; int nt;
    __device__ __forceinline__ void operator()(int m, int n, float v) const {
        v *= rstd_of(rssm[m]); const int col = nt * 16 + n; PM[m * PMW + col] = v; const bf16 hv = (bf16)f2bf(v);
        if (col >= 512 && col < 1024) { GAS bf16* dst = (GAS bf16*)Kb + (col - 512); dst[(size_t)m * DA] = hv; dst[(size_t)(LKV + m) * DA] = hv; }
        else if (col >= 1024 && col < 1536) { GAS bf16* dst = (GAS bf16*)Vb + (col - 1024); dst[(size_t)m * DA] = hv; dst[(size_t)(LKV + m) * DA] = hv; }
        else if (col >= 1536 && col < NIN) { const int j = (col - 1536) >> 8, ch = (col - 1536) & 255; GAS bf16* dst = (GAS bf16*)CB + (size_t)j * CB_STRIDE + ch; dst[(size_t)(32 + m) * 256] = hv; dst[(size_t)(LCV + 32 + m) * 256] = hv; }
    }
};
struct MEpiRes {
    const float* base; float* out; bf16* xm; float* rssm; int nt;
    __device__ __forceinline__ void operator()(int m, int n, float v) const {
        const int col = nt * 16 + n; const float o = base[m * D + col] + v; out[m * D + col] = o; xm[m * D + col] = (bf16)f2bf(o);
        float ss = o * o; ss += __shfl_xor(ss, 1); ss += __shfl_xor(ss, 2); ss += __shfl_xor(ss, 4); ss += __shfl_xor(ss, 8);
        if (n == 0) atomicAdd(rssm + m, ss);
    }
};
struct MEpiUp {
    bf16* hid; const float* rssm; int nt;
    __device__ __forceinline__ void operator()(int m, int n, float v) const { v = fmaxf(v * rstd_of(rssm[m]), 0.f); hid[m * FF + nt * 16 + n] = (bf16)f2bf(v * v); }
};

__device__ __forceinline__ void fgate_chunk(LAS unsigned char* lds, const bf16* XB, const bf16* Wf_t, const float* rowss, const float* bfv, float* LP, float* TOT, int ch, int tid, int wave, int lane) {
    int tid_l = tid; asm volatile("" : "+v"(tid_l)); tid = tid_l; lane = tid & 63;
    const int m0 = ch * 64, rt = wave & 3, kh = wave >> 2;
    const bf16* ap = XB + (size_t)(m0 + rt * 16 + (lane & 15)) * D + kh * 512 + 8 * (lane >> 4);
    const bf16* bp = Wf_t + (size_t)(lane & 15) * D + kh * 512 + 8 * (lane >> 4);
    f32x4 acc = {0.f, 0.f, 0.f, 0.f};
    for (int s = 0; s < 16; s += 4) {
        bf16x8 a[4], b[4];
#pragma unroll
        for (int i = 0; i < 4; ++i) { a[i] = *(const GAS bf16x8*)(ap + (s + i) * 32); b[i] = *(const GAS bf16x8*)(bp + (s + i) * 32); }
#pragma unroll
        for (int i = 0; i < 4; ++i) acc = __builtin_amdgcn_mfma_f32_16x16x32_bf16(a[i], b[i], acc, 0, 0, 0);
    }
    LAS float* F = (LAS float*)lds;
#pragma unroll
    for (int r = 0; r < 4; ++r) F[(kh * 64 + rt * 16 + (lane >> 4) * 4 + r) * 16 + (lane & 15)] = acc[r];
    __syncthreads();
    if (wave == 0) {
        const int b = ch >> 7, cl = ch & 127, t0 = cl * 64; const float rs = rstd_of(rowss[m0 + lane]);
#pragma unroll
        for (int j = 0; j < 8; ++j) {
            float c = logsig((F[lane * 16 + j] + F[(64 + lane) * 16 + j]) * rs + bfv[j]);
#pragma unroll
            for (int o = 1; o < 64; o <<= 1) { const float t = __shfl_up(c, o); if (lane >= o) c += t; }
            LP[(size_t)(b * 8 + j) * SEQ + t0 + lane] = c;
            if (lane == 63) TOT[(b * 8 + j) * 128 + cl] = c;
        }
    }
    __syncthreads();
}

__device__ __forceinline__ void build_xtab(LAS float* tab, LAS float* offs, const float* PM, const float* bfv, const float* LP, const float* TOT, int b, int h, int tid, int wave, int lane) {
    int tid_l = tid; asm volatile("" : "+v"(tid_l)); tid = tid_l; lane = tid & 63;
    if (wave == 0) {
        float c = (lane < 16) ? logsig(PM[lane * PMW + NIN + h] + bfv[h]) : 0.f;
#pragma unroll
        for (int o = 1; o < 16; o <<= 1) { const float t = __shfl_up(c, o); if (lane >= o) c += t; }
        const float cmtot = __shfl(c, 15);
        if (lane < 16) tab[lane] = -c * LOG2E;
        const float* tp = TOT + (b * 8 + h) * 128; const float v0 = tp[2 * lane], v1 = tp[2 * lane + 1]; const float pr = v0 + v1; float inc = pr;
#pragma unroll
        for (int o = 1; o < 64; o <<= 1) { const float t = __shfl_up(inc, o); if (lane >= o) inc += t; }
        const float ex = inc - pr + cmtot; offs[2 * lane] = ex; offs[2 * lane + 1] = ex + v0;
    }
    for (int i = 16 + tid; i < KPAD; i += NWAVES * 64) tab[i] = -1e30f;
    __syncthreads();
    const float* lp = LP + (size_t)(b * 8 + h) * SEQ;
    for (int t = tid; t < SEQ; t += NWAVES * 64) tab[KPAD + t] = -(offs[t >> 6] + lp[t]) * LOG2E;
    __syncthreads();
}

constexpr int CV_AT_OFF = 65536, CV_AT_PITCH = 528;
__device__ __forceinline__ void conv_chunk(LAS unsigned char* lds, const bf16* CBb, size_t p0, int n_out, bf16* dst, const float* wdw, const float* bdw, const float* lng, const float* lnb,
                                           const bf16* wpw_t, const float* bpw, const float* wsc, int tid, int wave, int lane) {
    int tid_l = tid; asm volatile("" : "+v"(tid_l)); tid = tid_l; lane = tid & 63;
    const bf16* CA = CBb; const bf16* CG = CBb + CB_STRIDE; const bf16* SBp = CBb + 2 * CB_STRIDE; const bf16* SCp = CBb + 3 * CB_STRIDE; const bf16* SUp = CBb + 4 * CB_STRIDE;
    LAS float* glu = (LAS float*)lds;
    for (int it = tid; it < 94 * 32; it += NWAVES * 64) { const int row = it >> 5, cg = (it & 31) * 8; const size_t off = (p0 - 30 + row) * 256 + cg;
        float a[8], g[8]; bf8_to_f(*(const GAS bf16x8*)(CA + off), a); bf8_to_f(*(const GAS bf16x8*)(CG + off), g);
        f32x4 o0, o1;
#pragma unroll
        for (int i = 0; i < 4; ++i) { o0[i] = a[i] * sigm(g[i]); o1[i] = a[4 + i] * sigm(g[4 + i]); }
        *(LAS f32x4*)(glu + row * 256 + cg) = o0; *(LAS f32x4*)(glu + row * 256 + cg + 4) = o1; }
    __syncthreads();
    const int ch = tid & 255, half = tid >> 8;
    float acc[32];
    { float w[CK];
#pragma unroll
      for (int k = 0; k < CK; ++k) w[k] = wdw[k * DC + ch];
      const float bias = bdw[ch];
#pragma unroll
      for (int grp = 0; grp < 4; ++grp) { float gv[38];
#pragma unroll
          for (int i = 0; i < 38; ++i) gv[i] = glu[(half * 32 + grp * 8 + i) * 256 + ch];
#pragma unroll
          for (int j = 0; j < 8; ++j) { float s = bias;
#pragma unroll
              for (int k = 0; k < CK; ++k) s = fmaf(w[k], gv[j + k], s);
              acc[grp * 8 + j] = s; } } }
    __syncthreads();
    LAS float* dw = (LAS float*)lds;
#pragma unroll
    for (int j = 0; j < 32; ++j) dw[(half * 32 + j) * 256 + ch] = acc[j];
    __syncthreads();
    { const f32x4 gq = *(const f32x4*)(lng + 4 * lane), bq = *(const f32x4*)(lnb + 4 * lane);
      for (int i = 0; i < 8; ++i) { const int row = wave * 8 + i; const f32x4 x = *(const LAS f32x4*)(dw + row * 256 + 4 * lane);
          const float mu = wave_sum((x[0] + x[1]) + (x[2] + x[3])) * (1.0f / DC); const f32x4 xc = x - mu;
          const float var = wave_sum((xc[0] * xc[0] + xc[1] * xc[1]) + (xc[2] * xc[2] + xc[3] * xc[3])) * (1.0f / DC); const float rs = 1.0f / sqrtf(var + EPS);
          f32x4 y = xc * rs * gq + bq;
#pragma unroll
          for (int e = 0; e < 4; ++e) y[e] = y[e] * sigm(y[e]);
          typedef unsigned u32x2v __attribute__((ext_vector_type(2))); u32x2v w; w.x = pk2(y[0], y[1]); w.y = pk2(y[2], y[3]);
          *(LAS u32x2v*)(lds + CV_AT_OFF + row * CV_AT_PITCH + 8 * lane) = w; } }
    __syncthreads();
    { f32x4 pacc[4][2];
#pragma unroll
      for (int mt = 0; mt < 4; ++mt) { pacc[mt][0] = (f32x4){0.f, 0.f, 0.f, 0.f}; pacc[mt][1] = (f32x4){0.f, 0.f, 0.f, 0.f}; }
      const int n0 = wave * 32;
#pragma unroll
      for (int ks = 0; ks < 8; ++ks) { bf16x8 wf[2], af[4];
#pragma unroll
          for (int nt = 0; nt < 2; ++nt) wf[nt] = *(const GAS bf16x8*)(wpw_t + (size_t)(n0 + nt * 16 + (lane & 15)) * DC + ks * 32 + 8 * (lane >> 4));
#pragma unroll
          for (int mt = 0; mt < 4; ++mt) af[mt] = *(const LAS bf16x8*)(lds + CV_AT_OFF + (mt * 16 + (lane & 15)) * CV_AT_PITCH + (ks * 32 + 8 * (lane >> 4)) * 2);
#pragma unroll
          for (int mt = 0; mt < 4; ++mt)
#pragma unroll
              for (int nt = 0; nt < 2; ++nt) pacc[mt][nt] = __builtin_amdgcn_mfma_f32_16x16x32_bf16(wf[nt], af[mt], pacc[mt][nt], 0, 0, 0); }
#pragma unroll
      for (int mt = 0; mt < 4; ++mt) { const int row = mt * 16 + (lane & 15);
#pragma unroll
          for (int nt = 0; nt < 2; ++nt) { const int n = n0 + nt * 16 + (lane >> 4) * 4; const f32x4 bb = *(const f32x4*)(bpw + n); const f32x4 v = pacc[mt][nt] + bb;
              typedef unsigned u32x2v __attribute__((ext_vector_type(2))); u32x2v w; w.x = pk2(v[0], v[1]); w.y = pk2(v[2], v[3]);
              if (row < n_out) *(GAS u32x2v*)(dst + (size_t)row * D + n) = w; } } }
    for (int it = tid; it < 64 * 32; it += NWAVES * 64) { const int row = it >> 5, cg = (it & 31) * 8; const size_t off = (p0 + row) * 256 + cg;
        float s[8];
#pragma unroll
        for (int e = 0; e < 8; ++e) s[e] = 0.f;
#pragma unroll
        for (int k = 0; k < SK; ++k) { float c[8], u[8]; bf8_to_f(*(const GAS bf16x8*)(SCp + off - (size_t)(SK - 1 - k) * 256), c); bf8_to_f(*(const GAS bf16x8*)(SUp + off - (size_t)(SK - 1 - k) * 256), u);
            const f32x4 w0 = *(const f32x4*)(wsc + k * DSC + cg), w1 = *(const f32x4*)(wsc + k * DSC + cg + 4);
#pragma unroll
            for (int e = 0; e < 4; ++e) { s[e] = fmaf(w0[e], c[e] * u[e], s[e]); s[4 + e] = fmaf(w1[e], c[4 + e] * u[4 + e], s[4 + e]); } }
        float bq[8]; bf8_to_f(*(const GAS bf16x8*)(SBp + off), bq);
        v4u w; w.x = pk2(bq[0] * s[0], bq[1] * s[1]); w.y = pk2(bq[2] * s[2], bq[3] * s[3]); w.z = pk2(bq[4] * s[4], bq[5] * s[5]); w.w = pk2(bq[6] * s[6], bq[7] * s[7]);
        if (row < n_out) *(GAS v4u*)(dst + (size_t)row * D + 256 + cg) = w; }
    __syncthreads();
}

__device__ __forceinline__ void meta_attn(LAS unsigned char* lds, const float* PM, const float* bfv, bf16* MIXM, int h, int lane) {
    asm volatile("" : "+v"(lane));
    LAS float* sm = (LAS float*)lds + h * 3072;
#pragma unroll 1
    for (int i = lane; i < 768; i += 64) { const int part = i >> 8, rem = i & 255, row = rem >> 4, c4 = (rem & 15) * 4;
        const f32x4 v = *(const GAS f32x4*)(PM + row * PMW + part * DA + h * HD + c4); *(LAS f32x4*)(sm + part * 1024 + row * 64 + c4) = v; }
    const int r = lane & 15, dq = lane >> 4;
    float c = logsig(PM[r * PMW + NIN + h] + bfv[h]);
#pragma unroll
    for (int o = 1; o < 16; o <<= 1) { const float t = __shfl_up(c, o, 16); if (r >= o) c += t; }
    const LAS float* qs = sm + r * 64 + dq * 16; const LAS float* ks = sm + 1024 + dq * 16; const LAS float* vs = sm + 2048 + dq * 16;
    float q[16];
#pragma unroll
    for (int i = 0; i < 16; ++i) q[i] = qs[i];
    float s[16]; float mx = -INFINITY;
#pragma unroll
    for (int kk = 0; kk < 16; ++kk) { float p = 0.f;
#pragma unroll
        for (int i = 0; i < 16; ++i) p = fmaf(q[i], ks[kk * 64 + i], p);
        p += __shfl_xor(p, 16); p += __shfl_xor(p, 32);
        const float ck = __shfl(c, kk, 16);
        p = (kk <= r) ? p * 0.125f + (c - ck) : -INFINITY; s[kk] = p; mx = fmaxf(mx, p); }
    float l = 0.f;
#pragma unroll
    for (int kk = 0; kk < 16; ++kk) { s[kk] = __expf(s[kk] - mx); l += s[kk]; }
    const float il = 1.0f / l;
    float o[16];
#pragma unroll
    for (int i = 0; i < 16; ++i) o[i] = 0.f;
#pragma unroll
    for (int kk = 0; kk < 16; ++kk)
#pragma unroll
        for (int i = 0; i < 16; ++i) o[i] = fmaf(s[kk], vs[kk * 64 + i], o[i]);
    v4u w0, w1; w0.x = pk2(o[0] * il, o[1] * il); w0.y = pk2(o[2] * il, o[3] * il); w0.z = pk2(o[4] * il, o[5] * il); w0.w = pk2(o[6] * il, o[7] * il);
    w1.x = pk2(o[8] * il, o[9] * il); w1.y = pk2(o[10] * il, o[11] * il); w1.z = pk2(o[12] * il, o[13] * il); w1.w = pk2(o[14] * il, o[15] * il);
    GAS v4u* dp = (GAS v4u*)(MIXM + r * D + h * HD + dq * 16); dp[0] = w0; dp[1] = w1;
}

struct Args { const float* in[17]; float* out; unsigned char* ws; int pad[2]; };
typedef const unsigned long long __attribute__((address_space(4)))* kargp_t;
#define KARGS() kargp_t kp = (kargp_t)__builtin_amdgcn_kernarg_segment_ptr(); asm volatile("" : "+s"(kp)); unsigned char* const ws = (unsigned char*)(GAS unsigned char*)kp[18]
#define KIN(i) ((const float*)(const GAS float*)kp[i])
#define KOUT ((float*)(GAS float*)kp[17])
#define RS(i) ((float*)(ws + RS_OFF) + (size_t)(i) * M)
#define RSMP ((float*)(ws + RSM_OFF))
__global__ void __launch_bounds__(NWAVES * 64, 2) fwd_mega(Args args) {
    extern __shared__ __attribute__((aligned(16))) unsigned char lds_raw[];
    LAS unsigned char* lds = (LAS unsigned char*)lds_raw;
    volatile LAS unsigned* MISC = (volatile LAS unsigned*)(lds + MISC_OFF);
    int tid = threadIdx.x, lane = tid & 63; const int wave = __builtin_amdgcn_readfirstlane(tid >> 6);
#define LAUNDER() do { tid = threadIdx.x; asm volatile("" : "+v"(tid)); lane = tid & 63; } while (0)
    const int G = gridDim.x, bx = blockIdx.x, vcu = (G % 8 == 0) ? (bx % 8) * (G / 8) + bx / 8 : bx;
    for (int u = tid; u < (LDS_BYTES - LDSCTL_OFF) / 4; u += NWAVES * 64) ((LAS unsigned*)(lds + LDSCTL_OFF))[u] = 0u;
    __syncthreads();
    (void)xcd_barrier_post((unsigned*)((gu32*)(args.ws + WS_CTL) + CW_BAR), MISC + 8);
#define GRID_BARRIER() do { KARGS(); XcdBarrier bb_; bb_.bar = (unsigned*)((gu32*)(ws + WS_CTL) + CW_BAR); bb_.x = xb_xcc_id(); bb_.st = MISC + 8; xcd_barrier(bb_); } while (0)
    const int gw = vcu * NWAVES + wave, NGW = G * NWAVES;

    {
        KARGS();
        const float* mix_g = KIN(2); const float* w_in = KIN(3);
        LAS float* scr = (LAS float*)(lds + RING_OFF + wave * 16384);
        constexpr int I_IN = (D / 64) * (NIN / 32), I_OUT = (D / 64) * (D / 32), I_1 = (D / 64) * (FF / 32), I_2 = (FF / 64) * (D / 32), I_PW = (DC / 64) * (DC / 32);
        constexpr int I_L = I_IN + I_OUT + I_1 + I_2 + I_PW;
        for (int it = gw; it < DEPTH * I_L; it += NGW) {
            const int l = it / I_L; int r = it % I_L;
            if (r < I_IN) { const int kb = r / (NIN / 32), nb = r % (NIN / 32), n0 = 32 * nb; p0_transpose_item(w_in + (size_t)l * D * NIN_SRC, NIN_SRC, n0 + (n0 >= 1536 ? 8 : 0), mix_g + l * D, (bf16*)(ws + WS_WIN + l * SZ_WIN), D, n0, scr, 64 * kb, lane); continue; } r -= I_IN;
            if (r < I_OUT) { const int kb = r / (D / 32), nb = r % (D / 32); p0_transpose_item(KIN(12) + (size_t)l * D * D, D, 32 * nb, nullptr, (bf16*)(ws + WS_WOUT + l * SZ_WOUT), D, 32 * nb, scr, 64 * kb, lane); continue; } r -= I_OUT;
            if (r < I_1) { const int kb = r / (FF / 32), nb = r % (FF / 32); p0_transpose_item(KIN(14) + (size_t)l * D * FF, FF, 32 * nb, KIN(13) + l * D, (bf16*)(ws + WS_W1 + l * SZ_W1), D, 32 * nb, scr, 64 * kb, lane); continue; } r -= I_1;
            if (r < I_2) { const int kb = r / (D / 32), nb = r % (D / 32); p0_transpose_item(KIN(15) + (size_t)l * FF * D, D, 32 * nb, nullptr, (bf16*)(ws + WS_W2 + l * SZ_W2), FF, 32 * nb, scr, 64 * kb, lane); continue; } r -= I_2;
            { const int kb = r / (DC / 32), nb = r % (DC / 32); p0_transpose_item(KIN(9) + (size_t)l * DC * DC, DC, 32 * nb, nullptr, (bf16*)(ws + WS_WPW + l * SZ_WPW), DC, 32 * nb, scr, 64 * kb, lane); }
        }
        LAUNDER();
        { const int idx = vcu * (NWAVES * 64) + tid; if (idx < DEPTH * 16 * D) { const int l = idx >> 14, j = (idx >> 10) & 15, k = idx & 1023;
            const float v = (j < 8) ? w_in[((size_t)l * D + k) * NIN_SRC + 1536 + j] * mix_g[l * D + k] : 0.f; ((bf16*)(ws + WS_WF))[idx] = (bf16)f2bf(v); } }
        { const float* x = KIN(0); bf16* XB = (bf16*)(ws + WS_XB);
          for (int m = gw; m < M; m += NGW) { const GAS f32x4* xr = (const GAS f32x4*)(x + (size_t)m * D) + lane; GAS unsigned long long* o8 = (GAS unsigned long long*)(XB + (size_t)m * D) + lane; float s = 0.f;
#pragma unroll
            for (int j = 0; j < 4; ++j) { const f32x4 v = xr[64 * j]; s += (v.x * v.x + v.y * v.y) + (v.z * v.z + v.w * v.w); o8[64 * j] = (unsigned long long)pk2(v.x, v.y) | ((unsigned long long)pk2(v.z, v.w) << 32); }
            s = wave_sum(s); if (lane == 0) RS(0)[m] = s; } }
        if (vcu == G - 1) { const float* meta = KIN(1); float* HM = (float*)(ws + WS_META + MO_HM); bf16* XM = (bf16*)(ws + WS_META + MO_XM);
          for (int r = wave; r < NMETA; r += NWAVES) { float s = 0.f;
            for (int j = 0; j < 4; ++j) { const f32x4 v = *((const GAS f32x4*)(meta + (size_t)r * D) + lane + 64 * j); s += (v.x * v.x + v.y * v.y) + (v.z * v.z + v.w * v.w);
                *((GAS f32x4*)(HM + (size_t)r * D) + lane + 64 * j) = v; *((GAS unsigned long long*)(XM + (size_t)r * D) + lane + 64 * j) = (unsigned long long)pk2(v.x, v.y) | ((unsigned long long)pk2(v.z, v.w) << 32); }
            s = wave_sum(s); if (lane == 0) RSMP[r] = s; } }
    }
    GRID_BARRIER();

    for (int l = 0; l < DEPTH; ++l) {
        {
            LAUNDER(); KARGS();
            bf16* XB = (bf16*)(ws + WS_XB); bf16* Qb = (bf16*)(ws + WS_Q); bf16* Kb = (bf16*)(ws + WS_K); bf16* Vb = (bf16*)(ws + WS_V); bf16* CBb = (bf16*)(ws + WS_CB);
            const bf16* Win_t = (const bf16*)(ws + WS_WIN + l * SZ_WIN); const bf16* Wf_t = (const bf16*)(ws + WS_WF + l * SZ_WF);
            { const int idx = vcu * (NWAVES * 64) + tid; v4u z; asm volatile("v_mov_b32 %0, 0\n\tv_mov_b32 %1, 0\n\tv_mov_b32 %2, 0\n\tv_mov_b32 %3, 0" : "=v"(z.x), "=v"(z.y), "=v"(z.z), "=v"(z.w));
              if (idx < 4 * 7168) { const int reg = idx / 7168, o = idx % 7168; bf16* base = ((reg & 1) ? Vb : Kb) + (size_t)((reg >> 1) * LKV + 16) * DA; ((GAS v4u*)base)[o] = z; }
              else if (idx < 4 * 7168 + 10 * 1024) { const int i2 = idx - 4 * 7168, reg = i2 >> 10, o = i2 & 1023; bf16* base = CBb + (size_t)(reg >> 1) * CB_STRIDE + (size_t)(reg & 1) * LCV * 256; ((GAS v4u*)base)[o] = z; } }
#ifndef SKIP_GA
            { pg8::Gemm g{XB, Win_t, M, NIN, D}; pg8::StaticOrder S; S.init(M, NIN, G, bx);
              pg8::EpiIn E{Qb, Kb, Vb, CBb, CB_STRIDE, RS(2 * l), C2};
              pg8::gemm_phase<pg8::EpiIn, pg8::StaticOrder, PG8_ALIGN, PG8_SP2>(lds + RING_OFF, g, S, E); }
#endif
#ifndef SKIP_SIDEA
            LAUNDER();
            if (bx >= 192) {
                const int si = bx - 192; const float* bfv = KIN(4) + l * NH;
                float* LP = (float*)(ws + WS_LP); float* TOT = (float*)(ws + WS_TOT); float* PM = (float*)(ws + WS_META + MO_PM); const bf16* XM = (const bf16*)(ws + WS_META + MO_XM);
                for (int ch = si; ch < M / 64; ch += 64) fgate_chunk(lds, XB, Wf_t, RS(2 * l), bfv, LP, TOT, ch, tid, wave, lane);
                for (int nt = si; nt < NIN / 16 + 1; nt += 64) { MEpiIn ME{PM, Kb, Vb, CBb, RSMP + 2 * l * 16, nt};
                    meta_gemm_item(lds, XM, D, (nt < NIN / 16) ? Win_t + (size_t)nt * 16 * D : Wf_t, D, 4, ME, tid, wave, lane); }
            }
#endif
        }
        GRID_BARRIER();
        {
            LAUNDER(); KARGS();
            bf16* Qb = (bf16*)(ws + WS_Q); bf16* Kb = (bf16*)(ws + WS_K); bf16* Vb = (bf16*)(ws + WS_V); bf16* CBb = (bf16*)(ws + WS_CB); bf16* MIX = (bf16*)(ws + WS_MIX);
            const float* PM = (const float*)(ws + WS_META + MO_PM); const float* bfv = KIN(4) + l * NH;
            const int bh = vcu >> 4, b = bh >> 3, h = bh & 7;
            LAS float* tab = (LAS float*)(lds + attn_body::LDS_TAB);
            build_xtab(tab, (LAS float*)(lds + attn_body::LDS_TOTAL), PM, bfv, (const float*)(ws + WS_LP), (const float*)(ws + WS_TOT), b, h, tid, wave, lane);
#ifndef SKIP_ATTN
            { const attn_body::AttnTensors AT{(const attn_body::bf16*)Qb, (const attn_body::bf16*)Kb, (const attn_body::bf16*)Vb, (attn_body::bf16*)MIX};
              const attn_body::StaticOrder S(G, bx);
              attn_body::attn_phase<attn_body::StaticOrder>((char*)lds_raw + RING_OFF, AT, S, (attn_body::lds_fptr)tab); }
#endif
            __syncthreads();
#ifndef SKIP_CONV
            { LAUNDER();
              const bf16* Wpw_t = (const bf16*)(ws + WS_WPW + l * SZ_WPW);
              const float* w_dw = KIN(5) + (size_t)l * CK * DC; const float* b_dw = KIN(6) + l * DC; const float* ln_g = KIN(7) + l * DC; const float* ln_b = KIN(8) + l * DC; const float* b_pw = KIN(10) + l * DC; const float* w_sc = KIN(11) + (size_t)l * SK * DSC;
              const int ch = vcu, cb = ch >> 7, t0 = (ch & 127) * 64;
              conv_chunk(lds, CBb, (size_t)cb * LCV + CPAD + t0, 64, MIX + (size_t)ch * 64 * D + DA, w_dw, b_dw, ln_g, ln_b, Wpw_t, b_pw, w_sc, tid, wave, lane);
              if (l == 0) { bf16* MIXM = (bf16*)(ws + WS_META + MO_MIXM);
                if (bx == 0) { meta_attn(lds, PM, bfv, MIXM, wave, lane); __syncthreads(); }
                if (bx == 1) conv_chunk(lds, CBb, 32, NMETA, MIXM + DA, w_dw, b_dw, ln_g, ln_b, Wpw_t, b_pw, w_sc, tid, wave, lane); } }
#endif
        }
        GRID_BARRIER();
        {
            LAUNDER(); KARGS();
            const bf16* Wout_t = (const bf16*)(ws + WS_WOUT + l * SZ_WOUT); bf16* XB = (bf16*)(ws + WS_XB); const bf16* MIX = (const bf16*)(ws + WS_MIX);
#ifndef SKIP_GC
            { pg8::Gemm g{MIX, Wout_t, M, D, D}; pg8::StaticOrder S; S.init(M, D, G, bx);
              pg8::EpiRes E{l == 0 ? KIN(0) : KOUT, KOUT, XB, RS(2 * l + 1)};
              pg8::gemm_phase<pg8::EpiRes, pg8::StaticOrder, false, PG8_SP2>(lds + RING_OFF, g, S, E); }
#endif
            LAUNDER();
            if (l == 0 && bx < 64) { MEpiRes ME{(const float*)(ws + WS_META + MO_HM), (float*)(ws + WS_META + MO_H1M), (bf16*)(ws + WS_META + MO_XM), RSMP + 16, bx};
                meta_gemm_item(lds, (const bf16*)(ws + WS_META + MO_MIXM), D, Wout_t + (size_t)bx * 16 * D, D, 4, ME, tid, wave, lane); }
        }
        GRID_BARRIER();
        {
            LAUNDER(); KARGS();
            const bf16* W1_t = (const bf16*)(ws + WS_W1 + l * SZ_W1); const bf16* XB = (const bf16*)(ws + WS_XB); bf16* HID = (bf16*)(ws + WS_HID);
#ifndef SKIP_GD
            { pg8::Gemm g{XB, W1_t, M, FF, D}; pg8::StaticOrder S; S.init(M, FF, G, bx);
              pg8::EpiUp E{HID, FF, RS(2 * l + 1)};
              pg8::gemm_phase<pg8::EpiUp, pg8::StaticOrder, PG8_ALIGN, PG8_SP2>(lds + RING_OFF, g, S, E); }
#endif
            LAUNDER();
            if (l == 0) { MEpiUp ME{(bf16*)(ws + WS_META + MO_HIDM), RSMP + 16, bx}; meta_gemm_item(lds, (const bf16*)(ws + WS_META + MO_XM), D, W1_t + (size_t)bx * 16 * D, D, 4, ME, tid, wave, lane); }
        }
        GRID_BARRIER();
        {
            LAUNDER(); KARGS();
            const bf16* W2_t = (const bf16*)(ws + WS_W2 + l * SZ_W2); bf16* XB = (bf16*)(ws + WS_XB); const bf16* HID = (const bf16*)(ws + WS_HID);
#ifndef SKIP_GE
            { pg8::Gemm g{HID, W2_t, M, D, FF}; pg8::StaticOrder S; S.init(M, D, G, bx);
              pg8::EpiRes E{KOUT, KOUT, XB, RS(2 * l + 2)};
              pg8::gemm_phase<pg8::EpiRes, pg8::StaticOrder, false, PG8_SP2>(lds + RING_OFF, g, S, E); }
#endif
            LAUNDER();
            if (l == 0 && bx < 64) { MEpiRes ME{(const float*)(ws + WS_META + MO_H1M), (float*)(ws + WS_META + MO_HM), (bf16*)(ws + WS_META + MO_XM), RSMP + 32, bx};
                meta_gemm_item(lds, (const bf16*)(ws + WS_META + MO_HIDM), FF, W2_t + (size_t)bx * 16 * FF, FF, 16, ME, tid, wave, lane); }
        }
        GRID_BARRIER();
    }
    {
        LAUNDER(); KARGS();
        float* out = KOUT; const float* fin_g = KIN(16);
        for (int m = gw; m < M; m += NGW) { GAS f32x4* orow = (GAS f32x4*)(out + (size_t)m * D) + lane; const float rs = rstd_of(RS(4)[m]);
#pragma unroll
            for (int j = 0; j < 4; ++j) { const f32x4 v = orow[64 * j]; const f32x4 gv = *((const GAS f32x4*)fin_g + lane + 64 * j); orow[64 * j] = v * rs * gv; } }
    }
}
#undef RS

extern "C" void kernel_launch(void* const* d_in, const int* in_sizes, int n_in, void* d_out, int out_size, void* d_ws, size_t ws_size, hipStream_t stream) {
    static int grid = 0;
    if (grid == 0) {
        if (n_in != 17 || in_sizes[0] != M * D || out_size != M * D || ws_size < WS_END) { fprintf(stderr, "kernel_launch: unexpected shapes (n_in %d, in0 %d, out %d, ws %zu); nothing launched\n", n_in, n_in > 0 ? in_sizes[0] : -1, out_size, ws_size); grid = -1; return; }
        int dev = 0, cus = 0, per_cu = 0;
        if (hipGetDevice(&dev) != hipSuccess || hipDeviceGetAttribute(&cus, hipDeviceAttributeMultiprocessorCount, dev) != hipSuccess) { grid = -1; return; }
        if (hipFuncSetAttribute((const void*)fwd_mega, hipFuncAttributeMaxDynamicSharedMemorySize, LDS_BYTES) != hipSuccess) { fprintf(stderr, "kernel_launch: hipFuncSetAttribute failed\n"); grid = -1; return; }
        if (hipOccupancyMaxActiveBlocksPerMultiprocessor(&per_cu, (const void*)fwd_mega, NWAVES * 64, LDS_BYTES) != hipSuccess || per_cu < 1) { fprintf(stderr, "kernel_launch: occupancy query reports %d workgroups per CU\n", per_cu); }
        (void)hipGetLastError();
        grid = cus;
        if (grid != 256) { fprintf(stderr, "kernel_launch: built for a 256-CU device, found %d CUs; nothing launched\n", grid); grid = -1; return; }
    }
    if (grid < 0) return;
    if (hipMemsetAsync((char*)d_ws + WS_CTL, 0, CTL_ZERO_BYTES, stream) != hipSuccess) return;
    Args a{};
    for (int i = 0; i < 17; ++i) a.in[i] = (const float*)d_in[i];
    a.out = (float*)d_out; a.ws = (unsigned char*)d_ws;
    hipLaunchKernelGGL(fwd_mega, dim3(grid), dim3(NWAVES * 64), LDS_BYTES, stream, a);
}
```
